# Optimizing an MI355X kernel written in HIP

```python
import jax, jax.numpy as jnp
from jax import lax
import numpy as np

D_MODEL = 1024
BATCH = 8
SEQ = 4096
DEPTH = 1

N_META = 16
CHUNK = 128
META_PAD = CHUNK - N_META
SSM_EXPAND = 2
D_INNER = SSM_EXPAND * D_MODEL
SSM_HEAD_DIM = 64
SSM_HEADS = D_INNER // SSM_HEAD_DIM
SSM_GROUPS = 4
D_STATE = 128
SSM_CONV = 4
CONV_DIM = D_INNER + 2 * SSM_GROUPS * D_STATE
ATTN_HEADS = 16
ATTN_KV_HEADS = 4
ATTN_HEAD_DIM = 64
ATTN_GROUP = ATTN_HEADS // ATTN_KV_HEADS
WINDOW = 128
ATTN_WIDTH = ATTN_HEADS * ATTN_HEAD_DIM
FFN_DIM = 2816
FFN_CONV = 3
N_IN = D_INNER + CONV_DIM + SSM_HEADS + (ATTN_HEADS + 2 * ATTN_KV_HEADS) * ATTN_HEAD_DIM + 2 * D_MODEL
EPS = 1e-6
NEG = -1e30

kernel_name = "hybrid_ssd_swa_sink_alibi_convffn"


def _rmsnorm(x, w):
    xf = x.astype(jnp.float32)
    y = xf * lax.rsqrt(jnp.mean(xf * xf, axis=-1, keepdims=True) + EPS)
    return (y * w.astype(jnp.float32)).astype(x.dtype)


def _causal_dwconv(u, w, b):
    k_width = w.shape[0]
    seq_len = u.shape[1]
    up = jnp.pad(u, ((0, 0), (k_width - 1, 0), (0, 0)))
    out = b.astype(u.dtype) + w[k_width - 1].astype(u.dtype) * u
    for k in range(k_width - 1):
        out = out + w[k].astype(u.dtype) * up[:, k:k + seq_len]
    return out


def _segsum_exp(a):
    t = a.shape[-1]
    cs = jnp.cumsum(a, axis=-1)
    mask = jnp.tril(jnp.ones((t, t), dtype=bool))
    diff = cs[..., :, None] - cs[..., None, :]
    return jnp.where(mask, jnp.exp(jnp.where(mask, diff, 0.0)), 0.0)


def _ssd_chunked(x_dt, a_dt, b_in, c_in):
    bsz, lp, n_heads, p_dim = x_dt.shape
    g, n = b_in.shape[2], b_in.shape[3]
    r = n_heads // g
    nc = lp // CHUNK
    xc = x_dt.reshape(bsz, nc, CHUNK, g, r, p_dim)
    ac = a_dt.reshape(bsz, nc, CHUNK, g, r).transpose(0, 3, 4, 1, 2)
    bc = b_in.reshape(bsz, nc, CHUNK, g, n)
    cc = c_in.reshape(bsz, nc, CHUNK, g, n)
    a_cs = jnp.cumsum(ac, axis=-1)
    lmat = _segsum_exp(ac)
    cb = jnp.einsum("bclgn,bcsgn->bgcls", cc, bc)
    y_diag = jnp.einsum("bgcls,bgrcls,bcsgrp->bclgrp", cb, lmat, xc)
    decay_states = jnp.exp(a_cs[..., -1:] - a_cs)
    states = jnp.einsum("bclgn,bgrcl,bclgrp->bcgrpn", bc, decay_states, xc)
    chunk_decay = jnp.exp(a_cs[..., -1])

    def step(h, inp):
        s_c, d_c = inp
        return h * d_c[..., None, None] + s_c, h

    h0 = jnp.zeros_like(states[:, 0])
    _, h_in = lax.scan(step, h0, (jnp.moveaxis(states, 1, 0), jnp.moveaxis(chunk_decay, -1, 0)))
    h_in = jnp.moveaxis(h_in, 0, 1)
    y_off = jnp.einsum("bclgn,bcgrpn,bgrcl->bclgrp", cc, h_in, jnp.exp(a_cs))
    return (y_diag + y_off).reshape(bsz, lp, n_heads, p_dim)


def _ssd_branch(z, xbc, dt_raw, conv_w, conv_b, dt_bias, a_log, d_skip, norm_w, w_out):
    bsz, seq_len, _ = xbc.shape
    xbc = jax.nn.silu(_causal_dwconv(xbc, conv_w, conv_b))
    xs, bs, cs = jnp.split(xbc, [D_INNER, D_INNER + SSM_GROUPS * D_STATE], axis=-1)
    xs = xs.reshape(bsz, seq_len, SSM_HEADS, SSM_HEAD_DIM).astype(jnp.float32)
    bs = bs.reshape(bsz, seq_len, SSM_GROUPS, D_STATE).astype(jnp.float32)
    cs = cs.reshape(bsz, seq_len, SSM_GROUPS, D_STATE).astype(jnp.float32)
    dt = jax.nn.softplus(dt_raw.astype(jnp.float32) + dt_bias.astype(jnp.float32))
    a = -jnp.exp(a_log.astype(jnp.float32))
    pad4 = ((0, 0), (META_PAD, 0), (0, 0), (0, 0))
    x_dt = jnp.pad(xs * dt[..., None], pad4)
    a_dt = jnp.pad(dt * a, ((0, 0), (META_PAD, 0), (0, 0)))
    y = _ssd_chunked(x_dt, a_dt, jnp.pad(bs, pad4), jnp.pad(cs, pad4))[:, META_PAD:]
    y = y + xs * d_skip.astype(jnp.float32)[:, None]
    y = y.reshape(bsz, seq_len, D_INNER).astype(z.dtype)
    y = _rmsnorm(y * jax.nn.silu(z), norm_w)
    return y @ w_out


def _swa_branch(q, k, v, sinks, w_out):
    bsz, seq_len, _ = q.shape
    lp = seq_len + META_PAD
    nb = lp // CHUNK
    scale = ATTN_HEAD_DIM ** -0.5
    q = q.reshape(bsz, seq_len, ATTN_KV_HEADS, ATTN_GROUP, ATTN_HEAD_DIM)
    k = k.reshape(bsz, seq_len, ATTN_KV_HEADS, ATTN_HEAD_DIM)
    v = v.reshape(bsz, seq_len, ATTN_KV_HEADS, ATTN_HEAD_DIM)
    qb = jnp.pad(q, ((0, 0), (META_PAD, 0), (0, 0), (0, 0), (0, 0))).reshape(
        bsz, nb, CHUNK, ATTN_KV_HEADS, ATTN_GROUP, ATTN_HEAD_DIM)
    kpad = ((0, 0), (META_PAD + CHUNK, 0), (0, 0), (0, 0))
    kp = jnp.pad(k, kpad).reshape(bsz, nb + 1, CHUNK, ATTN_KV_HEADS, ATTN_HEAD_DIM)
    vp = jnp.pad(v, kpad).reshape(bsz, nb + 1, CHUNK, ATTN_KV_HEADS, ATTN_HEAD_DIM)
    kb = jnp.concatenate([kp[:, :-1], kp[:, 1:]], axis=2)
    vb = jnp.concatenate([vp[:, :-1], vp[:, 1:]], axis=2)
    q_pos = jnp.arange(nb)[:, None] * CHUNK + jnp.arange(CHUNK)[None, :] - META_PAD
    k_pos = jnp.arange(nb)[:, None] * CHUNK + jnp.arange(2 * CHUNK)[None, :] - CHUNK - META_PAD
    dist = q_pos[:, :, None] - k_pos[:, None, :]
    band_ok = (dist >= 0) & (dist < WINDOW) & (k_pos[:, None, :] >= N_META)
    slopes = jnp.exp2(-8.0 * jnp.arange(1, ATTN_HEADS + 1, dtype=jnp.float32) / ATTN_HEADS)
    slopes = slopes.reshape(ATTN_KV_HEADS, ATTN_GROUP)
    s_band = jnp.einsum("bnqkgd,bnskd->bnkgqs", qb, kb, preferred_element_type=jnp.float32) * scale
    s_band = s_band - slopes[None, None, :, :, None, None] * dist.astype(jnp.float32)[None, :, None, None]
    s_band = jnp.where(band_ok[None, :, None, None], s_band, NEG)
    k_meta, v_meta = k[:, :N_META], v[:, :N_META]
    s_meta = jnp.einsum("bnqkgd,bmkd->bnkgqm", qb, k_meta, preferred_element_type=jnp.float32) * scale
    meta_ok = jnp.arange(N_META)[None, None, :] <= q_pos[:, :, None]
    s_meta = jnp.where(meta_ok[None, :, None, None], s_meta, NEG)
    sink = jnp.broadcast_to(sinks.astype(jnp.float32).reshape(ATTN_KV_HEADS, ATTN_GROUP)[None, None, :, :, None, None],
                            s_band.shape[:-1] + (1,))
    probs = jax.nn.softmax(jnp.concatenate([s_meta, s_band, sink], axis=-1), axis=-1).astype(v.dtype)
    out = (jnp.einsum("bnkgqm,bmkd->bnqkgd", probs[..., :N_META], v_meta)
           + jnp.einsum("bnkgqs,bnskd->bnqkgd", probs[..., N_META:N_META + 2 * CHUNK], vb))
    out = out.reshape(bsz, lp, ATTN_WIDTH)[:, META_PAD:]
    return out @ w_out


def _token_mixer(h, w_in, ssm_conv_w, ssm_conv_b, ssm_dt_bias, ssm_a_log, ssm_d_skip, ssm_norm,
                 w_ssm_out, attn_sinks, w_attn_out, w_mix_out):
    sizes = [D_INNER, CONV_DIM, SSM_HEADS, ATTN_WIDTH, ATTN_KV_HEADS * ATTN_HEAD_DIM,
             ATTN_KV_HEADS * ATTN_HEAD_DIM, 2 * D_MODEL]
    cuts = [int(c) for c in np.cumsum(sizes)[:-1]]
    z, xbc, dt_raw, q, k, v, gate_logits = jnp.split(h @ w_in, cuts, axis=-1)
    y_ssm = _ssd_branch(z, xbc, dt_raw, ssm_conv_w, ssm_conv_b, ssm_dt_bias, ssm_a_log, ssm_d_skip,
                        ssm_norm, w_ssm_out)
    y_attn = _swa_branch(q, k, v, attn_sinks, w_attn_out)
    gates = jax.nn.sigmoid(gate_logits.astype(jnp.float32)).astype(h.dtype)
    g_ssm, g_attn = jnp.split(gates, 2, axis=-1)
    return (g_ssm * y_ssm + g_attn * y_attn) @ w_mix_out


def _conv_ffn(h, w_up, conv_w, conv_b, w_down):
    u = _causal_dwconv(h @ w_up, conv_w, conv_b)
    a, g = jnp.split(u, 2, axis=-1)
    return (jax.nn.silu(a) * g) @ w_down


def setup_inputs(seed: int = 0) -> dict:
    key = jax.random.key(seed)
    ks = jax.random.split(key, 24)
    f32 = jnp.float32

    def nrm(k, shape, scale):
        return jax.random.normal(k, shape, f32) * scale

    def gain(k, dim):
        return 1.0 + nrm(k, (DEPTH, dim), 0.01)

    dt0 = jnp.exp(jax.random.uniform(ks[6], (DEPTH, SSM_HEADS), f32, np.log(1e-3), np.log(1e-1)))
    return {
        "x": nrm(ks[0], (BATCH, SEQ, D_MODEL), 1.0),
        "meta_tokens": nrm(ks[1], (N_META, D_MODEL), 1.0),
        "norm_pre_mix": gain(ks[2], D_MODEL),
        "w_in": nrm(ks[3], (DEPTH, D_MODEL, N_IN), D_MODEL ** -0.5),
        "ssm_conv_w": nrm(ks[4], (DEPTH, SSM_CONV, CONV_DIM), 0.5 * SSM_CONV ** -0.5),
        "ssm_conv_b": nrm(ks[5], (DEPTH, CONV_DIM), 0.01),
        "ssm_dt_bias": dt0 + jnp.log(-jnp.expm1(-dt0)),
        "ssm_a_log": jnp.log(jax.random.uniform(ks[7], (DEPTH, SSM_HEADS), f32, 1.0, 16.0)),
        "ssm_d_skip": 1.0 + nrm(ks[8], (DEPTH, SSM_HEADS), 0.01),
        "ssm_norm": gain(ks[9], D_INNER),
        "w_ssm_out": nrm(ks[10], (DEPTH, D_INNER, D_MODEL), D_INNER ** -0.5),
        "attn_sinks": nrm(ks[11], (DEPTH, ATTN_HEADS), 1.0),
        "w_attn_out": nrm(ks[12], (DEPTH, ATTN_WIDTH, D_MODEL), ATTN_WIDTH ** -0.5),
        "w_mix_out": nrm(ks[13], (DEPTH, D_MODEL, D_MODEL), D_MODEL ** -0.5),
        "norm_post_mix": gain(ks[14], D_MODEL),
        "norm_pre_ffn": gain(ks[15], D_MODEL),
        "w_ffn_up": nrm(ks[16], (DEPTH, D_MODEL, 2 * FFN_DIM), D_MODEL ** -0.5),
        "ffn_conv_w": nrm(ks[17], (DEPTH, FFN_CONV, 2 * FFN_DIM), 0.5 * FFN_CONV ** -0.5),
        "ffn_conv_b": nrm(ks[18], (DEPTH, 2 * FFN_DIM), 0.01),
        "w_ffn_down": nrm(ks[19], (DEPTH, FFN_DIM, D_MODEL), FFN_DIM ** -0.5),
        "norm_post_ffn": gain(ks[20], D_MODEL),
    }


def reference(x, meta_tokens, norm_pre_mix, w_in, ssm_conv_w, ssm_conv_b, ssm_dt_bias, ssm_a_log,
              ssm_d_skip, ssm_norm, w_ssm_out, attn_sinks, w_attn_out, w_mix_out, norm_post_mix,
              norm_pre_ffn, w_ffn_up, ffn_conv_w, ffn_conv_b, w_ffn_down, norm_post_ffn):
    bsz = x.shape[0]
    meta = jnp.broadcast_to(meta_tokens.astype(x.dtype)[None], (bsz, N_META, D_MODEL))
    h = jnp.concatenate([meta, x], axis=1)
    for l in range(DEPTH):
        mix = _token_mixer(_rmsnorm(h, norm_pre_mix[l]), w_in[l], ssm_conv_w[l], ssm_conv_b[l],
                           ssm_dt_bias[l], ssm_a_log[l], ssm_d_skip[l], ssm_norm[l], w_ssm_out[l],
                           attn_sinks[l], w_attn_out[l], w_mix_out[l])
        h = h + _rmsnorm(mix, norm_post_mix[l])
        ffn = _conv_ffn(_rmsnorm(h, norm_pre_ffn[l]), w_ffn_up[l], ffn_conv_w[l], ffn_conv_b[l], w_ffn_down[l])
        h = h + _rmsnorm(ffn, norm_post_ffn[l])
    return h[:, N_META:]
```

```cpp
#include <hip/hip_runtime.h>
#include <hip/hip_cooperative_groups.h>
#include <cstdio>
namespace cg = cooperative_groups;

#define LAS __attribute__((address_space(3)))
typedef unsigned short bf16_t;
typedef short bf16x8 __attribute__((ext_vector_type(8)));
typedef float f32x4 __attribute__((ext_vector_type(4)));
typedef unsigned u32x4 __attribute__((ext_vector_type(4)));

#ifndef ONE_LAUNCH
#define ONE_LAUNCH 0
#endif

constexpr int D = 1024, SEQ = 4096, NMETA = 16, NPOS = SEQ + NMETA;
constexpr int XROWS = 32768, MROWS = 33024, META_TILE = 128;
constexpr int PROJ_LD = 8704, NIN_PAD = 8960;
constexpr int C_Z = 0, C_XS = 2048, C_Q = 5120, C_K = 6144, C_V = 6400, C_GS = 6656, C_GA = 7680;
constexpr int A2_LD = 3072, FF = 2816, U_LD = 5632;
constexpr float EPS = 1e-6f;
constexpr size_t MiB = 1048576;
constexpr size_t OFF_WDN = 0, OFF_WUP = 6 * MiB, OFF_WMIX = 17 * MiB, OFF_WG2 = 19 * MiB, OFF_WIN = 25 * MiB, OFF_DT = 43 * MiB, OFF_SSQ = 48 * MiB,
                 OFF_PROJ_META = 53 * MiB, OFF_A2_META = 58 * MiB, OFF_HN_META = 60 * MiB, OFF_MBUF_META = 61 * MiB, OFF_PROJ_X = 64 * MiB, OFF_A2_X = 336 * MiB,
                 OFF_MIX = 64 * MiB, OFF_U = 17 * MiB, OFF_HN2 = 372 * MiB, OFF_FFN = 372 * MiB, OFF_HALO = 502 * MiB, WS_NEED = 506 * MiB;
constexpr int LDS_BYTES = 131072;
constexpr int NPHASE = 13;

struct Params {
    const float* in[21];
    float* out;
    unsigned char* ws;
    int ph_lo, ph_hi;
};

__device__ __forceinline__ int otid() { int t = threadIdx.x; asm volatile("" : "+v"(t)); return t; }
__device__ __forceinline__ int obid() { int t = blockIdx.x; asm volatile("" : "+s"(t)); return t; }
__device__ __forceinline__ float bf2f(unsigned b) { return __uint_as_float(b << 16); }
__device__ __forceinline__ unsigned cvt_pk_bf16(float lo, float hi) { unsigned r; asm volatile("v_cvt_pk_bf16_f32 %0, %1, %2" : "=v"(r) : "v"(lo), "v"(hi)); return r; }
__device__ __forceinline__ void unpack8(const u32x4 v, float* f) {
#pragma unroll
    for (int i = 0; i < 4; ++i) { f[2 * i] = __uint_as_float(v[i] << 16); f[2 * i + 1] = __uint_as_float(v[i] & 0xffff0000u); }
}
__device__ __forceinline__ u32x4 pack8(const float* f) { u32x4 o; o.x = cvt_pk_bf16(f[0], f[1]); o.y = cvt_pk_bf16(f[2], f[3]); o.z = cvt_pk_bf16(f[4], f[5]); o.w = cvt_pk_bf16(f[6], f[7]); return o; }
__device__ __forceinline__ float wave_sum(float v) {
#pragma unroll
    for (int o = 1; o < 64; o <<= 1) v += __shfl_xor(v, o);
    return v;
}
__device__ __forceinline__ float wave_max(float v) {
#pragma unroll
    for (int o = 1; o < 64; o <<= 1) v = fmaxf(v, __shfl_xor(v, o));
    return v;
}
__device__ __forceinline__ float silu_f(float x) { return x / (1.f + __expf(-x)); }
__device__ __forceinline__ float sigmoid_f(float x) { return 1.f / (1.f + __expf(-x)); }
__device__ __forceinline__ int rowof(int b, int p) { return p < NMETA ? XROWS + p : b * SEQ + p - NMETA; }
__device__ __forceinline__ const bf16_t* proj_row(const unsigned char* ws, int r) {
    return r >= XROWS ? (const bf16_t*)(ws + OFF_PROJ_META) + (size_t)(r - XROWS) * PROJ_LD : (const bf16_t*)(ws + OFF_PROJ_X) + (size_t)(r & 16383) * PROJ_LD;
}
__device__ __forceinline__ bf16_t* a2_row(unsigned char* ws, int r) {
    return r >= XROWS ? (bf16_t*)(ws + OFF_A2_META) + (size_t)(r - XROWS) * A2_LD : (bf16_t*)(ws + OFF_A2_X) + (size_t)(r & 16383) * A2_LD;
}

namespace pg8 {
constexpr int BM = 256, BK = 64, HALF = 128, HTB = HALF * BK * 2, NXCD = 8, WGM = 8;
__device__ __forceinline__ int lds_byte(int r, int c) { const int st = (r >> 4) * 2 + (c >> 5), rr = r & 15, cc = c & 31, ob = rr * 64 + cc * 2; return st * 1024 + (ob ^ (((ob >> 9) & 1) << 5)); }
__device__ __forceinline__ void stage_rc(int b, int& R, int& C) { const int st = b / 1024, sb = b % 1024, swz = sb ^ (((sb >> 9) & 1) << 5); R = (st >> 1) * 16 + swz / 64; C = (st & 1) * 32 + (swz % 64) / 2; }
__device__ __forceinline__ int perm32(int rho) { const int n = rho >> 4, i = rho & 15; return 8 * (i >> 2) + 4 * n + (i & 3); }

struct Unit { const char* A; const char* B; int nt; int pm; int pn; int kind; };

struct Sched {
    int nM, nN, nwg, G, c, parts, mt0, has_meta, nt0, nt1;
    const char *Ax, *Am, *B; size_t a_tile, b_tile;
    __device__ bool next(int j, Unit& u) const {
        const int i = parts == 2 ? (j >> 1) : j, part = parts == 2 ? (j & 1) : 0;
        const long L = (long)i * G + c; if (L >= nwg) return false;
        int wgid = (int)L; { const int q = nwg / NXCD, r = nwg % NXCD, xcd = wgid % NXCD, off = wgid / NXCD; wgid = (xcd < r ? xcd * (q + 1) : r * (q + 1) + (xcd - r) * q) + off; }
        const int nig = WGM * nN, gid = wgid / nig, fm = gid * WGM, gsz = (nM - fm) < WGM ? (nM - fm) : WGM;
        const int pml = fm + ((wgid % nig) % gsz), pn = (wgid % nig) / gsz;
        const bool meta = has_meta && pml == nM - 1;
        u.pm = meta ? META_TILE : mt0 + pml; u.pn = pn;
        const size_t ko = part ? (size_t)nt0 * (BK * 2) : 0;
        u.A = (meta ? Am : Ax + (size_t)pml * a_tile) + ko; u.B = B + (size_t)pn * b_tile + ko;
        u.nt = part ? nt1 : nt0; u.kind = parts == 2 ? part + 1 : 0;
        return true;
    }
};

template <class Epi>
__device__ __forceinline__ void gemm_phase(LAS unsigned char* lds, const int lda, const int ldb, const Sched& S, const Epi& E) {
    const int tid = otid(), wid = __builtin_amdgcn_readfirstlane(tid >> 6), lane = tid & 63, wr = wid >> 2, wc = wid & 3, fr = lane & 15, fq = lane >> 4;
    unsigned voffA[2], voffB[2];
#pragma unroll
    for (int i = 0; i < 2; ++i) { int R, C; stage_rc(tid * 16 + i * 8192, R, C); const int Rb = (R & ~31) + perm32(R & 31);
        voffA[i] = (unsigned)(R * lda + C) * 2u; voffB[i] = (unsigned)(Rb * ldb + C) * 2u; }
    const size_t kstep = (size_t)(BK * 2);
    const size_t hstepA = (size_t)HALF * lda * 2, hstepB = (size_t)HALF * ldb * 2;
    const unsigned ldsw = (unsigned)wid * 1024u;
    const int aoff = lds_byte(wr * 64 + fr, fq * 8), boff = lds_byte(wc * 32 + fr, fq * 8);
#define PG8_SA(b, h) (((b) * 2 + (h)) * HTB)
#define PG8_SB(b, h) ((4 + (b) * 2 + (h)) * HTB)
#define PG8_STAGE(bufoff, gbase, voff) do { _Pragma("unroll") for (int _i = 0; _i < 2; ++_i) \
        __builtin_amdgcn_global_load_lds((const unsigned*)((const char*)(gbase) + (voff)[_i]), (LAS unsigned*)(lds + (bufoff) + ldsw + _i * 8192), 16, 0, 0); } while (0)
#define PG8_LDA(dst, b, h) do { _Pragma("unroll") for (int m = 0; m < 4; ++m) _Pragma("unroll") for (int k = 0; k < 2; ++k) dst[m][k] = *(const LAS bf16x8*)(lds + PG8_SA(b, h) + aoff + m * 2048 + k * 1024); } while (0)
#define PG8_LDB(dst, b, h) do { _Pragma("unroll") for (int n = 0; n < 2; ++n) _Pragma("unroll") for (int k = 0; k < 2; ++k) dst[n][k] = *(const LAS bf16x8*)(lds + PG8_SB(b, h) + boff + n * 2048 + k * 1024); } while (0)
#define PG8_MMA(ai, bj, At, Bt) do { __builtin_amdgcn_s_setprio(1); _Pragma("unroll") for (int m = 0; m < 4; ++m) _Pragma("unroll") for (int n = 0; n < 2; ++n) _Pragma("unroll") for (int k = 0; k < 2; ++k) \
        acc[ai][bj][m][n] = __builtin_amdgcn_mfma_f32_16x16x32_bf16(Bt[n][k], At[m][k], acc[ai][bj][m][n], 0, 0, 0); __builtin_amdgcn_s_setprio(0); } while (0)
#define PG8_WAIT_V(n) asm volatile("s_waitcnt vmcnt(" #n ")" ::: "memory")
#define PG8_WAIT_L(n) asm volatile("s_waitcnt lgkmcnt(" #n ")" ::: "memory")
#define PG8_BAR __builtin_amdgcn_s_barrier()
#define PG8_SCHED __builtin_amdgcn_sched_barrier(0)
    Unit cur, nxt; int ui = 0;
    if (!S.next(0, cur)) return;
    f32x4 acc[2][2][4][2];
#pragma unroll
    for (int a = 0; a < 2; ++a)
#pragma unroll
        for (int b = 0; b < 2; ++b)
#pragma unroll
            for (int m = 0; m < 4; ++m)
#pragma unroll
                for (int n = 0; n < 2; ++n) acc[a][b][m][n] = (f32x4){0.f, 0.f, 0.f, 0.f};
    bf16x8 At[4][2], B0[2][2], B1[2][2];
    const char* cA = cur.A; const char* cB = cur.B;
    PG8_STAGE(PG8_SB(0, 0), cB, voffB); PG8_STAGE(PG8_SA(0, 0), cA, voffA); PG8_STAGE(PG8_SB(0, 1), cB + hstepB, voffB); PG8_STAGE(PG8_SA(0, 1), cA + hstepA, voffA);
    if (wr == 1) PG8_BAR;
    PG8_WAIT_V(4); PG8_BAR;
    PG8_STAGE(PG8_SB(1, 0), cB + kstep, voffB); PG8_STAGE(PG8_SA(1, 0), cA + kstep, voffA); PG8_STAGE(PG8_SB(1, 1), cB + hstepB + kstep, voffB);
    PG8_WAIT_V(6); PG8_BAR;
    for (;;) {
        const bool has_next = S.next(ui + 1, nxt);
        const char* nA = has_next ? nxt.A : cA; const char* nB = has_next ? nxt.B : cB;
        const int nt = cur.nt;
        for (int t = 0; t < nt; t += 2) {
            const bool last = (t == nt - 2);
            const char* a1 = cA + (size_t)(t + 1) * kstep;
            const char* a2 = last ? nA : cA + (size_t)(t + 2) * kstep; const char* b2 = last ? nB : cB + (size_t)(t + 2) * kstep;
            const char* a3 = a2 + kstep; const char* b3 = b2 + kstep;
            PG8_LDB(B0, 0, 0); PG8_SCHED; PG8_LDA(At, 0, 0); PG8_STAGE(PG8_SA(1, 1), a1 + hstepA, voffA);
            PG8_WAIT_L(8); PG8_BAR; PG8_WAIT_L(0); PG8_MMA(0, 0, At, B0); PG8_BAR; PG8_SCHED;
            PG8_LDB(B1, 0, 1); PG8_STAGE(PG8_SB(0, 0), b2, voffB);
            PG8_BAR; PG8_WAIT_L(0); PG8_MMA(0, 1, At, B1); PG8_BAR;
            PG8_LDA(At, 0, 1); PG8_STAGE(PG8_SA(0, 0), a2, voffA);
            PG8_BAR; PG8_WAIT_L(0); PG8_MMA(1, 0, At, B0); PG8_BAR; PG8_SCHED;
            PG8_STAGE(PG8_SB(0, 1), b2 + hstepB, voffB);
            PG8_WAIT_V(6); PG8_BAR; PG8_MMA(1, 1, At, B1); PG8_BAR;
            PG8_LDB(B0, 1, 0); PG8_SCHED; PG8_LDA(At, 1, 0); PG8_STAGE(PG8_SA(0, 1), a2 + hstepA, voffA);
            PG8_WAIT_L(8); PG8_BAR; PG8_WAIT_L(0); PG8_MMA(0, 0, At, B0); PG8_BAR; PG8_SCHED;
            PG8_LDB(B1, 1, 1); PG8_STAGE(PG8_SB(1, 0), b3, voffB);
            PG8_BAR; PG8_WAIT_L(0); PG8_MMA(0, 1, At, B1); PG8_BAR;
            PG8_LDA(At, 1, 1); PG8_STAGE(PG8_SA(1, 0), a3, voffA);
            PG8_BAR; PG8_WAIT_L(0); PG8_MMA(1, 0, At, B0); PG8_BAR; PG8_SCHED;
            PG8_STAGE(PG8_SB(1, 1), b3 + hstepB, voffB);
            PG8_WAIT_V(6); PG8_BAR; PG8_MMA(1, 1, At, B1); PG8_BAR;
        }
        E(acc, cur, wr, wc, fr, fq);
        if (!has_next) break;
        if (cur.kind != 1) {
#pragma unroll
            for (int a = 0; a < 2; ++a)
#pragma unroll
                for (int b = 0; b < 2; ++b)
#pragma unroll
                    for (int m = 0; m < 4; ++m)
#pragma unroll
                        for (int n = 0; n < 2; ++n) acc[a][b][m][n] = (f32x4){0.f, 0.f, 0.f, 0.f};
        }
        cur = nxt; cA = nA; cB = nB; ++ui;
    }
    PG8_WAIT_V(0);
    if (wr == 0) PG8_BAR;
    PG8_BAR;
#undef PG8_SA
#undef PG8_SB
#undef PG8_STAGE
#undef PG8_LDA
#undef PG8_LDB
#undef PG8_MMA
#undef PG8_WAIT_V
#undef PG8_WAIT_L
#undef PG8_BAR
#undef PG8_SCHED
}
}
using pg8::Unit;
typedef f32x4 Acc[2][2][4][2];

struct EpiG1 {
    unsigned char* ws;
    __device__ __forceinline__ void operator()(Acc& acc, const Unit& u, int wr, int wc, int fr, int fq) const {
#pragma unroll
        for (int ai = 0; ai < 2; ++ai)
#pragma unroll
            for (int m = 0; m < 4; ++m) {
                const int lr = 128 * ai + 64 * wr + 16 * m + fr;
                if (u.pn < 34) {
                    bf16_t* rp = (u.pm == META_TILE ? (bf16_t*)(ws + OFF_PROJ_META) + (size_t)lr * PROJ_LD : (bf16_t*)(ws + OFF_PROJ_X) + (size_t)((u.pm & 63) * 256 + lr) * PROJ_LD) + 256 * u.pn + 32 * wc + 8 * fq;
#pragma unroll
                    for (int bj = 0; bj < 2; ++bj) { u32x4 o; o.x = cvt_pk_bf16(acc[ai][bj][m][0][0], acc[ai][bj][m][0][1]); o.y = cvt_pk_bf16(acc[ai][bj][m][0][2], acc[ai][bj][m][0][3]);
                        o.z = cvt_pk_bf16(acc[ai][bj][m][1][0], acc[ai][bj][m][1][1]); o.w = cvt_pk_bf16(acc[ai][bj][m][1][2], acc[ai][bj][m][1][3]); *(u32x4*)(rp + 128 * bj) = o; }
                } else if (wc == 0) {
                    float* dp = (float*)(ws + OFF_DT) + (size_t)(u.pm * 256 + lr) * 32 + 8 * fq;
                    *(f32x4*)dp = acc[ai][0][m][0]; *(f32x4*)(dp + 4) = acc[ai][0][m][1];
                }
            }
    }
};
struct EpiG2 {
    unsigned char* ws; bf16_t* mbuf_x;
    __device__ __forceinline__ void operator()(Acc& acc, const Unit& u, int wr, int wc, int fr, int fq) const {
#pragma unroll
        for (int ai = 0; ai < 2; ++ai)
#pragma unroll
            for (int m = 0; m < 4; ++m) {
                const int lr = 128 * ai + 64 * wr + 16 * m + fr, grow = u.pm * 256 + lr, c8 = 256 * u.pn + 32 * wc + 8 * fq;
                const bf16_t* pr = proj_row(ws, grow);
                if (u.kind == 1) {
                    const f32x4* sq = (const f32x4*)((const float*)(ws + OFF_SSQ) + (size_t)grow * 32);
                    float s = 0.f;
#pragma unroll
                    for (int i = 0; i < 8; ++i) { const f32x4 v = sq[i]; s += (v[0] + v[1]) + (v[2] + v[3]); }
                    const float rs = rsqrtf(s * (1.f / 2048.f) + EPS);
#pragma unroll
                    for (int bj = 0; bj < 2; ++bj) {
                        float gs[8], ga[8]; unpack8(*(const u32x4*)(pr + C_GS + c8 + 128 * bj), gs); unpack8(*(const u32x4*)(pr + C_GA + c8 + 128 * bj), ga);
#pragma unroll
                        for (int j = 0; j < 8; ++j) { const float a = fminf(fmaxf(ga[j], -60.f), 60.f), g = fminf(fmaxf(gs[j], -60.f), 60.f);
                            acc[ai][bj][m][j >> 2][j & 3] *= rs * (1.f + __expf(-a)) / (1.f + __expf(-g)); }
                    }
                } else {
                    bf16_t* op = (u.pm == META_TILE ? (bf16_t*)(ws + OFF_MBUF_META) + (size_t)lr * D : mbuf_x + (size_t)grow * D) + c8;
#pragma unroll
                    for (int bj = 0; bj < 2; ++bj) {
                        float ga[8], o[8]; unpack8(*(const u32x4*)(pr + C_GA + c8 + 128 * bj), ga);
#pragma unroll
                        for (int j = 0; j < 8; ++j) { const float a = fminf(fmaxf(ga[j], -60.f), 60.f); o[j] = acc[ai][bj][m][j >> 2][j & 3] / (1.f + __expf(-a)); }
                        *(u32x4*)(op + 128 * bj) = pack8(o);
                    }
                }
            }
    }
};
struct EpiF32 {
    float* C;
    __device__ __forceinline__ void operator()(Acc& acc, const Unit& u, int wr, int wc, int fr, int fq) const {
#pragma unroll
        for (int ai = 0; ai < 2; ++ai)
#pragma unroll
            for (int m = 0; m < 4; ++m) {
                float* rp = C + (size_t)(u.pm * 256 + 128 * ai + 64 * wr + 16 * m + fr) * D + 256 * u.pn + 32 * wc + 8 * fq;
#pragma unroll
                for (int bj = 0; bj < 2; ++bj) { *(f32x4*)(rp + 128 * bj) = acc[ai][bj][m][0]; *(f32x4*)(rp + 128 * bj + 4) = acc[ai][bj][m][1]; }
            }
    }
};
struct EpiG4 {
    bf16_t* U; bf16_t* halo;
    __device__ __forceinline__ void operator()(Acc& acc, const Unit& u, int wr, int wc, int fr, int fq) const {
#pragma unroll
        for (int ai = 0; ai < 2; ++ai)
#pragma unroll
            for (int m = 0; m < 4; ++m) {
                const int lr = 128 * ai + 64 * wr + 16 * m + fr, col = 256 * u.pn + 32 * wc + 8 * fq;
                bf16_t* rp = U + (size_t)(u.pm * 256 + lr) * U_LD + col;
                const bool h = (u.pm == META_TILE) ? (lr == 14 || lr == 15) : (lr >= 254);
                bf16_t* hp = halo + (size_t)(u.pm * 2 + (lr & 1)) * U_LD + col;
#pragma unroll
                for (int bj = 0; bj < 2; ++bj) { u32x4 o; o.x = cvt_pk_bf16(acc[ai][bj][m][0][0], acc[ai][bj][m][0][1]); o.y = cvt_pk_bf16(acc[ai][bj][m][0][2], acc[ai][bj][m][0][3]);
                    o.z = cvt_pk_bf16(acc[ai][bj][m][1][0], acc[ai][bj][m][1][1]); o.w = cvt_pk_bf16(acc[ai][bj][m][1][2], acc[ai][bj][m][1][3]); *(u32x4*)(rp + 128 * bj) = o;
                    if (h) *(u32x4*)(hp + 128 * bj) = o; }
            }
    }
};

__device__ __forceinline__ void tr_item(const float* W, int ldn, int k0, int n0src, bool zero, const float* kscale, bf16_t* WT, int ldk, int nrow0, int kcol0, LAS float* scr, int lane) {
#pragma unroll 8
    for (int i = 0; i < 32; ++i) { const int kk = 2 * i + (lane >> 5); float v = zero ? 0.f : W[(size_t)(k0 + kk) * ldn + n0src + (lane & 31)]; if (kscale) v *= kscale[k0 + kk]; scr[kk * 33 + (lane & 31)] = v; }
    asm volatile("s_waitcnt lgkmcnt(0)" ::: "memory");
    const int c = lane & 7;
#pragma unroll
    for (int j = 0; j < 4; ++j) { const int n = (lane >> 3) + 8 * j; const LAS float* s = scr + (8 * c) * 33 + n;
        u32x4 o; o.x = cvt_pk_bf16(s[0 * 33], s[1 * 33]); o.y = cvt_pk_bf16(s[2 * 33], s[3 * 33]); o.z = cvt_pk_bf16(s[4 * 33], s[5 * 33]); o.w = cvt_pk_bf16(s[6 * 33], s[7 * 33]);
        *(u32x4*)(WT + (size_t)(nrow0 + n) * ldk + kcol0 + k0 + 8 * c) = o; }
    asm volatile("s_waitcnt lgkmcnt(0)" ::: "memory");
}
__device__ __forceinline__ void phase_prep(const Params& p, LAS unsigned char* lds) {
    const int tid_ = otid(), lane = tid_ & 63, wave = tid_ >> 6, gw = obid() * 8 + wave, NGW = gridDim.x * 8;
    LAS float* scr = (LAS float*)(lds + wave * 8448);
    constexpr int I_IN = 280 * 16, I_SSM = 32 * 32, I_AT = 16 * 32, I_MIX = 16 * 32, I_UP = 16 * 176, I_DN = 44 * 32;
    constexpr int NIT = I_IN + I_SSM + I_AT + I_MIX + I_UP + I_DN;
    for (int it = gw; it < NIT; it += NGW) {
        int r = it;
        if (r < I_IN) { const int nb = r % 280, kb = r / 280; const int srcb = nb < 160 ? nb : (nb < 272 ? nb + 1 : 160);
            tr_item(p.in[3], 8736, 64 * kb, 32 * srcb, nb > 272, nullptr, (bf16_t*)(p.ws + OFF_WIN), 1024, 32 * nb, 0, scr, lane); continue; } r -= I_IN;
        if (r < I_SSM) { const int nb = r % 32, kb = r / 32; tr_item(p.in[10], 1024, 64 * kb, 32 * nb, false, p.in[9], (bf16_t*)(p.ws + OFF_WG2), 3072, 32 * nb, 0, scr, lane); continue; } r -= I_SSM;
        if (r < I_AT) { const int nb = r % 32, kb = r / 32; tr_item(p.in[12], 1024, 64 * kb, 32 * nb, false, nullptr, (bf16_t*)(p.ws + OFF_WG2), 3072, 32 * nb, 2048, scr, lane); continue; } r -= I_AT;
        if (r < I_MIX) { const int nb = r % 32, kb = r / 32; tr_item(p.in[13], 1024, 64 * kb, 32 * nb, false, nullptr, (bf16_t*)(p.ws + OFF_WMIX), 1024, 32 * nb, 0, scr, lane); continue; } r -= I_MIX;
        if (r < I_UP) { const int nb = r % 176, kb = r / 176; tr_item(p.in[16], 5632, 64 * kb, 32 * nb, false, nullptr, (bf16_t*)(p.ws + OFF_WUP), 1024, 32 * nb, 0, scr, lane); continue; } r -= I_UP;
        { const int nb = r % 32, kb = r / 32; tr_item(p.in[19], 1024, 64 * kb, 32 * nb, false, nullptr, (bf16_t*)(p.ws + OFF_WDN), 2816, 32 * nb, 0, scr, lane); }
    }
    const float* w = p.in[2];
    for (int r = gw; r < MROWS; r += NGW) {
        bf16_t* dst = r < XROWS ? (bf16_t*)p.out + (size_t)r * D : (bf16_t*)(p.ws + OFF_HN_META) + (size_t)(r - XROWS) * D;
        if (r >= XROWS + NMETA) {
#pragma unroll
            for (int j = 0; j < 2; ++j) *(u32x4*)(dst + (lane + 64 * j) * 8) = (u32x4){0u, 0u, 0u, 0u};
            continue;
        }
        const float* src = r < XROWS ? p.in[0] + (size_t)r * D : p.in[1] + (size_t)(r - XROWS) * D;
        f32x4 v[4]; float s = 0.f;
#pragma unroll
        for (int j = 0; j < 4; ++j) { v[j] = *(const f32x4*)(src + (lane + 64 * j) * 4); s += (v[j][0] * v[j][0] + v[j][1] * v[j][1]) + (v[j][2] * v[j][2] + v[j][3] * v[j][3]); }
        const float rs = rsqrtf(wave_sum(s) * (1.f / D) + EPS);
#pragma unroll
        for (int j = 0; j < 4; ++j) { const f32x4 wv = *(const f32x4*)(w + (lane + 64 * j) * 4);
            uint2 o; o.x = cvt_pk_bf16(v[j][0] * rs * wv[0], v[j][1] * rs * wv[1]); o.y = cvt_pk_bf16(v[j][2] * rs * wv[2], v[j][3] * rs * wv[3]);
            *(uint2*)(dst + (lane + 64 * j) * 4) = o; }
    }
}

__device__ __forceinline__ void ssd_item(const Params& p, LAS unsigned char* lds, int b, int head) {
    unsigned char* ws = p.ws;
    const int t = otid(), grp = head >> 3;
    LAS float* xs_s = (LAS float*)lds;
    LAS float* B_s = xs_s + 32 * 64;
    LAS float* C_s = B_s + 32 * 128;
    LAS float* y_s = C_s + 32 * 128;
    LAS float* dt_s = y_s + 32 * 64;
    LAS float* dA_s = dt_s + 32;
    const float* cw = p.in[4]; const float* cb = p.in[5];
    const float dtb = p.in[6][head], Aneg = -__expf(p.in[7][head]), Dsk = p.in[8][head];
    const int pp = t >> 3, n0 = (t & 7) * 16;
    float h[16];
#pragma unroll
    for (int j = 0; j < 16; ++j) h[j] = 0.f;
    for (int t0 = 0; t0 < NPOS;) {
        const int cnt = t0 == 0 ? 16 : 32;
        __syncthreads();
        for (int task = t; task < cnt * 40; task += 512) {
            const int tk = task / 40, cgp = task % 40, pos = t0 + tk;
            const int ch = cgp < 8 ? head * 64 + cgp * 8 : (cgp < 24 ? 2048 + grp * 128 + (cgp - 8) * 8 : 2560 + grp * 128 + (cgp - 24) * 8);
            float a[8];
#pragma unroll
            for (int j = 0; j < 8; ++j) a[j] = cb[ch + j];
#pragma unroll
            for (int k = 0; k < 4; ++k) { const int ps = pos - 3 + k;
                if (ps >= 0) { float u[8]; unpack8(*(const u32x4*)(proj_row(ws, rowof(b, ps)) + C_XS + ch), u);
#pragma unroll
                    for (int j = 0; j < 8; ++j) a[j] += cw[k * 3072 + ch + j] * u[j]; } }
            LAS float* dst = cgp < 8 ? xs_s + tk * 64 + cgp * 8 : (cgp < 24 ? B_s + tk * 128 + (cgp - 8) * 8 : C_s + tk * 128 + (cgp - 24) * 8);
#pragma unroll
            for (int j = 0; j < 8; ++j) dst[j] = silu_f(a[j]);
        }
        if (t < cnt) { const float raw = ((const float*)(ws + OFF_DT))[(size_t)rowof(b, t0 + t) * 32 + head] + dtb; const float dt = raw > 20.f ? raw : log1pf(__expf(raw)); dt_s[t] = dt; dA_s[t] = __expf(dt * Aneg); }
        __syncthreads();
        for (int tk = 0; tk < cnt; ++tk) {
            const float dA = dA_s[tk], xr = xs_s[tk * 64 + pp], xv = xr * dt_s[tk];
            float part = 0.f;
#pragma unroll
            for (int q = 0; q < 4; ++q) { const f32x4 bv = *(const LAS f32x4*)(B_s + tk * 128 + n0 + 4 * q), cv = *(const LAS f32x4*)(C_s + tk * 128 + n0 + 4 * q);
#pragma unroll
                for (int j = 0; j < 4; ++j) { h[4 * q + j] = h[4 * q + j] * dA + xv * bv[j]; part += cv[j] * h[4 * q + j]; } }
            part += __shfl_xor(part, 1); part += __shfl_xor(part, 2); part += __shfl_xor(part, 4);
            if ((t & 7) == 0) y_s[tk * 64 + pp] = part + Dsk * xr;
        }
        __syncthreads();
        if (t < cnt * 8 && (t0 > 0 || b == 0)) {
            const int tk = t >> 3, pg = t & 7, row = rowof(b, t0 + tk);
            float z[8], o[8]; unpack8(*(const u32x4*)(proj_row(ws, row) + C_Z + head * 64 + pg * 8), z);
            float ss = 0.f;
#pragma unroll
            for (int j = 0; j < 8; ++j) { o[j] = y_s[tk * 64 + pg * 8 + j] * silu_f(z[j]); ss += o[j] * o[j]; }
            *(u32x4*)(a2_row(ws, row) + head * 64 + pg * 8) = pack8(o);
            ss += __shfl_xor(ss, 1); ss += __shfl_xor(ss, 2); ss += __shfl_xor(ss, 4);
            if (pg == 0) ((float*)(ws + OFF_SSQ))[(size_t)row * 32 + head] = ss;
        }
        t0 += cnt;
    }
    __syncthreads();
}

__device__ __forceinline__ void attn_item(const Params& p, LAS unsigned char* lds, int b, int qb, int kv) {
    unsigned char* ws = p.ws;
    const int t = otid(), lane = t & 63, wave = t >> 6, P0 = qb * 64;
    LAS float* K_s = (LAS float*)lds;
    LAS float* V_s = K_s + 208 * 65;
    LAS float* P_s = V_s + 208 * 64 + wave * 208;
    __syncthreads();
    for (int task = t; task < 207 * 8; task += 512) {
        const int idx = task >> 3, dg = task & 7;
        const int kpos = idx < 16 ? idx : P0 - 127 + (idx - 16);
        float kf[8], vf[8];
        if (kpos >= (idx < 16 ? 0 : 16) && kpos < NPOS) { const bf16_t* pr = proj_row(ws, rowof(b, kpos)); unpack8(*(const u32x4*)(pr + C_K + kv * 64 + dg * 8), kf); unpack8(*(const u32x4*)(pr + C_V + kv * 64 + dg * 8), vf); }
        else {
#pragma unroll
            for (int j = 0; j < 8; ++j) { kf[j] = 0.f; vf[j] = 0.f; } }
#pragma unroll
        for (int j = 0; j < 8; ++j) { K_s[idx * 65 + dg * 8 + j] = kf[j]; V_s[idx * 64 + dg * 8 + j] = vf[j]; }
    }
    __syncthreads();
    for (int pair = wave; pair < 256; pair += 8) {
        const int ri = pair >> 2, g = pair & 3, pos = P0 + ri, hq = kv * 4 + g;
        if (pos >= NPOS || (pos < NMETA && b != 0)) continue;
        const int row = rowof(b, pos);
        const bf16_t* qp = proj_row(ws, row) + C_Q + hq * 64;
        float q[64];
#pragma unroll
        for (int i = 0; i < 8; ++i) unpack8(*(const u32x4*)(qp + 8 * i), q + 8 * i);
        const float slope = exp2f(-0.5f * (float)(hq + 1)), sink = p.in[11][hq];
        float sc[4];
#pragma unroll
        for (int c = 0; c < 4; ++c) {
            const int idx = c * 64 + lane; float s = -1e30f;
            if (idx < 207) {
                bool ok; float pen = 0.f;
                if (idx < 16) ok = idx <= pos;
                else { const int kpos = P0 - 127 + (idx - 16), dist = pos - kpos; ok = dist >= 0 && dist < 128 && kpos >= NMETA; pen = slope * (float)dist; }
                if (ok) { float d = 0.f;
#pragma unroll
                    for (int e = 0; e < 64; ++e) d += q[e] * K_s[idx * 65 + e];
                    s = d * 0.125f - pen; }
            }
            sc[c] = s;
        }
        float mx = fmaxf(fmaxf(sc[0], sc[1]), fmaxf(sc[2], sc[3])); mx = fmaxf(wave_max(mx), sink);
        float sum = 0.f;
#pragma unroll
        for (int c = 0; c < 4; ++c) { const float e = sc[c] > -1e29f ? __expf(sc[c] - mx) : 0.f; sum += e; if (c * 64 + lane < 208) P_s[c * 64 + lane] = e; }
        sum = wave_sum(sum) + __expf(sink - mx);
        asm volatile("s_waitcnt lgkmcnt(0)" ::: "memory");
        float o = 0.f;
        for (int idx = 0; idx < 207; ++idx) o += P_s[idx] * V_s[idx * 64 + lane];
        a2_row(ws, row)[2048 + hq * 64 + lane] = (bf16_t)(cvt_pk_bf16(o / sum, 0.f) & 0xffffu);
        asm volatile("s_waitcnt lgkmcnt(0)" ::: "memory");
    }
    __syncthreads();
}

__device__ __forceinline__ void phase_mixer(const Params& p, LAS unsigned char* lds, int half) {
    const int c = obid(), G = gridDim.x;
    const int nssd = 128, nattn = 4 * 65 * 4;
    const int GS = G / 2;
    if (c < GS) { for (int it = c; it < nssd; it += GS) ssd_item(p, lds, half * 4 + (it >> 5), it & 31); }
    else { for (int it = c - GS; it < nattn; it += G - GS) { const int kv = it & 3, r = it >> 2, qb = r % 65, bl = r / 65; attn_item(p, lds, half * 4 + bl, qb, kv); } }
}

__device__ __forceinline__ void phase_e1(const Params& p) {
    const int tid_ = otid(), lane = tid_ & 63, gw = obid() * 8 + (tid_ >> 6), NGW = gridDim.x * 8;
    const float* w1 = p.in[14]; const float* w2 = p.in[15];
    for (int r = gw; r < MROWS; r += NGW) {
        bf16_t* dst = (bf16_t*)(p.ws + OFF_HN2) + (size_t)r * D;
        if (r >= XROWS + NMETA) {
#pragma unroll
            for (int j = 0; j < 2; ++j) *(u32x4*)(dst + (lane + 64 * j) * 8) = (u32x4){0u, 0u, 0u, 0u};
            continue;
        }
        const float* mx = (const float*)(p.ws + OFF_MIX) + (size_t)r * D;
        const float* hs = r < XROWS ? p.in[0] + (size_t)r * D : p.in[1] + (size_t)(r - XROWS) * D;
        f32x4 v[4]; float s = 0.f;
#pragma unroll
        for (int j = 0; j < 4; ++j) { v[j] = *(const f32x4*)(mx + (lane + 64 * j) * 4); s += (v[j][0] * v[j][0] + v[j][1] * v[j][1]) + (v[j][2] * v[j][2] + v[j][3] * v[j][3]); }
        const float rs1 = rsqrtf(wave_sum(s) * (1.f / D) + EPS);
        float s2 = 0.f;
#pragma unroll
        for (int j = 0; j < 4; ++j) { const f32x4 hv = *(const f32x4*)(hs + (lane + 64 * j) * 4), wv = *(const f32x4*)(w1 + (lane + 64 * j) * 4);
#pragma unroll
            for (int i = 0; i < 4; ++i) { v[j][i] = hv[i] + v[j][i] * rs1 * wv[i]; s2 += v[j][i] * v[j][i]; } }
        const float rs2 = rsqrtf(wave_sum(s2) * (1.f / D) + EPS);
#pragma unroll
        for (int j = 0; j < 4; ++j) { const f32x4 wv = *(const f32x4*)(w2 + (lane + 64 * j) * 4);
            if (r < XROWS) *(f32x4*)(p.out + (size_t)r * D + (lane + 64 * j) * 4) = v[j];
            uint2 o; o.x = cvt_pk_bf16(v[j][0] * rs2 * wv[0], v[j][1] * rs2 * wv[1]); o.y = cvt_pk_bf16(v[j][2] * rs2 * wv[2], v[j][3] * rs2 * wv[3]);
            *(uint2*)(dst + (lane + 64 * j) * 4) = o; }
    }
}
__device__ __forceinline__ void phase_e3(const Params& p) {
    const int tid_ = otid(), lane = tid_ & 63, gw = obid() * 8 + (tid_ >> 6), NGW = gridDim.x * 8;
    const float* w3 = p.in[20];
    for (int r = gw; r < XROWS; r += NGW) {
        const float* fx = (const float*)(p.ws + OFF_FFN) + (size_t)r * D;
        f32x4 v[4]; float s = 0.f;
#pragma unroll
        for (int j = 0; j < 4; ++j) { v[j] = *(const f32x4*)(fx + (lane + 64 * j) * 4); s += (v[j][0] * v[j][0] + v[j][1] * v[j][1]) + (v[j][2] * v[j][2] + v[j][3] * v[j][3]); }
        const float rs = rsqrtf(wave_sum(s) * (1.f / D) + EPS);
#pragma unroll
        for (int j = 0; j < 4; ++j) { float* op = p.out + (size_t)r * D + (lane + 64 * j) * 4; const f32x4 hv = *(const f32x4*)op, wv = *(const f32x4*)(w3 + (lane + 64 * j) * 4);
            f32x4 o;
#pragma unroll
            for (int i = 0; i < 4; ++i) o[i] = hv[i] + v[j][i] * rs * wv[i];
            *(f32x4*)op = o; }
    }
}
__device__ __forceinline__ void phase_e2(const Params& p) {
    const int t = otid(), tc = t & 7, tr = t >> 3;
    bf16_t* U = (bf16_t*)(p.ws + OFF_U); const bf16_t* halo = (const bf16_t*)(p.ws + OFF_HALO);
    const float* cw = p.in[17]; const float* cb = p.in[18];
    for (int it = obid(); it < 129 * 44; it += gridDim.x) {
        const int pm = it / 44, slab = it % 44, c = slab * 64 + tc * 8, lr0 = tr * 4;
        float ua[6][8], ug[6][8];
#pragma unroll
        for (int k = 0; k < 6; ++k) {
            const int lr = lr0 - 2 + k;
            const bf16_t* src;
            bool zero = false;
            if (lr >= 0) src = U + (size_t)(pm * 256 + lr) * U_LD;
            else if (pm == META_TILE) { zero = true; src = U; }
            else src = halo + (size_t)(((pm & 15) == 0 ? META_TILE : pm - 1) * 2 + (lr + 2)) * U_LD;
            if (zero) {
#pragma unroll
                for (int j = 0; j < 8; ++j) { ua[k][j] = 0.f; ug[k][j] = 0.f; } }
            else { unpack8(*(const u32x4*)(src + c), ua[k]); unpack8(*(const u32x4*)(src + FF + c), ug[k]); }
        }
        float wa[3][8], wg[3][8], ba[8], bg[8];
#pragma unroll
        for (int j = 0; j < 8; ++j) { ba[j] = cb[c + j]; bg[j] = cb[FF + c + j];
#pragma unroll
            for (int k = 0; k < 3; ++k) { wa[k][j] = cw[k * 5632 + c + j]; wg[k][j] = cw[k * 5632 + FF + c + j]; } }
        u32x4 o[4];
#pragma unroll
        for (int i = 0; i < 4; ++i) { float r[8];
#pragma unroll
            for (int j = 0; j < 8; ++j) { const float a = ba[j] + wa[2][j] * ua[i + 2][j] + wa[1][j] * ua[i + 1][j] + wa[0][j] * ua[i][j];
                const float g = bg[j] + wg[2][j] * ug[i + 2][j] + wg[1][j] * ug[i + 1][j] + wg[0][j] * ug[i][j]; r[j] = silu_f(a) * g; }
            o[i] = pack8(r); }
        __syncthreads();
#pragma unroll
        for (int i = 0; i < 4; ++i) *(u32x4*)(U + (size_t)(pm * 256 + lr0 + i) * U_LD + c) = o[i];
        __syncthreads();
    }
}

__device__ __forceinline__ void sched_init(pg8::Sched& S, int nM, int nN, int parts, int mt0, int has_meta, int nt0, int nt1, const void* Ax, const void* Am, const void* B, size_t a_tile, size_t b_tile) {
    S.nM = nM; S.nN = nN; S.nwg = nM * nN; S.G = gridDim.x; S.c = obid(); S.parts = parts; S.mt0 = mt0; S.has_meta = has_meta; S.nt0 = nt0; S.nt1 = nt1;
    S.Ax = (const char*)Ax; S.Am = (const char*)Am; S.B = (const char*)B; S.a_tile = a_tile; S.b_tile = b_tile;
}
__device__ __forceinline__ void run_phase(const Params& p, LAS unsigned char* lds, int ph) {
    unsigned char* ws = p.ws;
    pg8::Sched S;
    switch (ph) {
#ifndef PHM
#define PHM 0x1fff
#endif
#define PH_ON(x) ((PHM >> (x)) & 1)
    case 0: if (PH_ON(0)) phase_prep(p, lds); break;
    case 1: case 4: if (PH_ON(1)) { const int half = ph == 4;
        sched_init(S, half ? 64 : 65, 35, 1, half * 64, !half, 16, 0, (const char*)p.out + (size_t)half * 64 * 256 * D * 2, ws + OFF_HN_META, ws + OFF_WIN, (size_t)256 * D * 2, (size_t)256 * D * 2);
        EpiG1 E{ws}; pg8::gemm_phase(lds, D, D, S, E); } break;
    case 2: case 5: if (PH_ON(2)) phase_mixer(p, lds, ph == 5); break;
    case 3: case 6: if (PH_ON(3)) { const int half = ph == 6;
        sched_init(S, half ? 64 : 65, 4, 2, half * 64, !half, 32, 16, ws + OFF_A2_X, ws + OFF_A2_META, ws + OFF_WG2, (size_t)256 * A2_LD * 2, (size_t)256 * A2_LD * 2);
        EpiG2 E{ws, (bf16_t*)((unsigned char*)p.out + 64 * MiB)}; pg8::gemm_phase(lds, A2_LD, A2_LD, S, E); } break;
    case 7: if (PH_ON(7)) { sched_init(S, 129, 4, 1, 0, 1, 16, 0, (unsigned char*)p.out + 64 * MiB, ws + OFF_MBUF_META, ws + OFF_WMIX, (size_t)256 * D * 2, (size_t)256 * D * 2);
        EpiF32 E{(float*)(ws + OFF_MIX)}; pg8::gemm_phase(lds, D, D, S, E); } break;
    case 8: if (PH_ON(8)) phase_e1(p); break;
    case 9: if (PH_ON(9)) { sched_init(S, 129, 22, 1, 0, 1, 16, 0, ws + OFF_HN2, ws + OFF_HN2 + (size_t)128 * 256 * D * 2, ws + OFF_WUP, (size_t)256 * D * 2, (size_t)256 * D * 2);
        EpiG4 E{(bf16_t*)(ws + OFF_U), (bf16_t*)(ws + OFF_HALO)}; pg8::gemm_phase(lds, D, D, S, E); } break;
    case 10: if (PH_ON(10)) phase_e2(p); break;
    case 11: if (PH_ON(11)) { sched_init(S, 129, 4, 1, 0, 1, 44, 0, ws + OFF_U, ws + OFF_U + (size_t)128 * 256 * U_LD * 2, ws + OFF_WDN, (size_t)256 * U_LD * 2, (size_t)256 * FF * 2);
        EpiF32 E{(float*)(ws + OFF_FFN)}; pg8::gemm_phase(lds, U_LD, FF, S, E); } break;
    case 12: if (PH_ON(12)) phase_e3(p); break;
    }
}

__global__ __launch_bounds__(512, 2) void fwd_kernel(Params p) {
    extern __shared__ __attribute__((aligned(16))) unsigned char shm[];
    LAS unsigned char* lds = (LAS unsigned char*)shm;
    for (int ph = p.ph_lo; ph < p.ph_hi; ++ph) {
        run_phase(p, lds, ph);
        if (ph + 1 < p.ph_hi) { cg::this_grid().sync(); }
    }
}

extern "C" void kernel_launch(void* const* d_in, const int* in_sizes, int n_in, void* d_out, int out_size, void* d_ws, size_t ws_size, hipStream_t stream) {
    static int grid = 0;
    if (grid == 0) {
        if (n_in != 21 || ws_size < WS_NEED) { fprintf(stderr, "kernel_launch: unexpected n_in %d / ws_size %zu\n", n_in, ws_size); grid = -1; return; }
        int dev = 0, cus = 0, per_cu = 0;
        hipGetDevice(&dev); hipDeviceGetAttribute(&cus, hipDeviceAttributeMultiprocessorCount, dev);
        hipFuncSetAttribute((const void*)fwd_kernel, hipFuncAttributeMaxDynamicSharedMemorySize, LDS_BYTES);
        hipOccupancyMaxActiveBlocksPerMultiprocessor(&per_cu, (const void*)fwd_kernel, 512, LDS_BYTES);
        if (per_cu < 1) { fprintf(stderr, "kernel_launch: occupancy query says %d\n", per_cu); per_cu = 1; }
        grid = cus;
    }
    if (grid < 0) return;
    Params p{};
    for (int i = 0; i < 21; ++i) p.in[i] = (const float*)d_in[i];
    p.out = (float*)d_out; p.ws = (unsigned char*)d_ws;
#if ONE_LAUNCH
    p.ph_lo = 0; p.ph_hi = NPHASE;
    void* args[] = {&p};
    hipError_t e = hipLaunchCooperativeKernel((const void*)fwd_kernel, dim3(grid), dim3(512), args, LDS_BYTES, stream);
    if (e != hipSuccess) fprintf(stderr, "cooperative launch failed: %s (grid %d)\n", hipGetErrorString(e), grid);
#else
    for (int ph = 0; ph < NPHASE; ++ph) {
        p.ph_lo = ph; p.ph_hi = ph + 1;
        hipLaunchKernelGGL(fwd_kernel, dim3(grid), dim3(512), LDS_BYTES, stream, p);
    }
#endif
}
```

```cpp
#include <hip/hip_runtime.h>
#include <hip/hip_cooperative_groups.h>
#include <cstdio>
namespace cg = cooperative_groups;

#define LAS __attribute__((address_space(3)))
typedef unsigned short bf16_t;
typedef short bf16x8 __attribute__((ext_vector_type(8)));
typedef float f32x4 __attribute__((ext_vector_type(4)));
typedef unsigned u32x4 __attribute__((ext_vector_type(4)));
typedef unsigned u32x2 __attribute__((ext_vector_type(2)));

#ifndef ONE_LAUNCH
#define ONE_LAUNCH 1
#endif

constexpr int D = 1024, SEQ = 4096, NMETA = 16, NPOS = SEQ + NMETA;
constexpr int XROWS = 32768, MROWS = 33024, META_TILE = 128;
constexpr int PROJ_LD = 6656, NIN_PAD = 8960;
constexpr int C_Z = 0, C_XS = 2048, C_Q = 5120, C_K = 6144, C_V = 6400, C_GS = 2048, C_GA = 3072;
constexpr int A2_LD = 3072, FF = 2816, U_LD = 5632;
constexpr float EPS = 1e-6f;
constexpr size_t MiB = 1048576;
constexpr size_t OFF_WDN = 0, OFF_WUP = 6 * MiB, OFF_WMIX = 17 * MiB, OFF_WG2 = 19 * MiB, OFF_WIN = 25 * MiB, OFF_DT = 43 * MiB, OFF_SSQ = 48 * MiB,
                 OFF_HN_META = 60 * MiB, OFF_MBUF_META = 61 * MiB, OFF_PROJ = 64 * MiB,
                 OFF_MIX = 240 * MiB, OFF_U = 17 * MiB, OFF_HN2 = 372 * MiB, OFF_FFN = 372 * MiB, OFF_HALO = 502 * MiB, OFF_HALO1 = 505 * MiB, OFF_BAR = 508 * MiB, WS_NEED = 509 * MiB,
                 OFF_RAW = 200 * MiB, OFF_RAWM = 230 * MiB,
                 OFF_RAW1 = 483 * MiB + MiB / 2, OFF_RAW1M = 505 * MiB;
constexpr int LDS_BYTES = 131072 + 16;
constexpr int NPHASE = 10;

struct Params {
    const float* in[21];
    float* out;
    unsigned char* ws;
    int ph_lo, ph_hi;
};

__device__ __forceinline__ int otid() { int t = threadIdx.x; asm volatile("" : "+v"(t)); return t; }
__device__ __forceinline__ int obid() { int t = blockIdx.x; asm volatile("" : "+s"(t)); return t; }
__device__ __forceinline__ void lds_barrier() { asm volatile("s_waitcnt lgkmcnt(0)\n\ts_barrier" ::: "memory"); }
__device__ __forceinline__ float bf2f(unsigned b) { return __uint_as_float(b << 16); }
typedef float f32x2_t __attribute__((ext_vector_type(2)));
typedef __bf16 bf16x2_t __attribute__((ext_vector_type(2)));
__device__ __forceinline__ unsigned cvt_pk_bf16(float lo, float hi) { const f32x2_t v = {lo, hi}; return __builtin_bit_cast(unsigned, __builtin_convertvector(v, bf16x2_t)); }
__device__ __forceinline__ void unpack8(const u32x4 v, float* f) {
#pragma unroll
    for (int i = 0; i < 4; ++i) { f[2 * i] = __uint_as_float(v[i] << 16); f[2 * i + 1] = __uint_as_float(v[i] & 0xffff0000u); }
}
__device__ __forceinline__ u32x4 pack8(const float* f) { u32x4 o; o.x = cvt_pk_bf16(f[0], f[1]); o.y = cvt_pk_bf16(f[2], f[3]); o.z = cvt_pk_bf16(f[4], f[5]); o.w = cvt_pk_bf16(f[6], f[7]); return o; }
__device__ __forceinline__ float wave_sum(float v) {
#pragma unroll
    for (int o = 1; o < 64; o <<= 1) v += __shfl_xor(v, o);
    return v;
}
__device__ __forceinline__ float wave_max(float v) {
#pragma unroll
    for (int o = 1; o < 64; o <<= 1) v = fmaxf(v, __shfl_xor(v, o));
    return v;
}
__device__ __forceinline__ float silu_f(float x) { return x * __builtin_amdgcn_rcpf(1.f + __expf(-x)); }
__device__ __forceinline__ float sigmoid_f(float x) { return __builtin_amdgcn_rcpf(1.f + __expf(-x)); }
__device__ __forceinline__ int rowof(int b, int p) { return p < NMETA ? XROWS + p : b * SEQ + p - NMETA; }
__device__ __forceinline__ const bf16_t* proj_row(const unsigned char* ws, int r) {
    return (const bf16_t*)(ws + OFF_PROJ) + (size_t)r * PROJ_LD;
}

namespace pg8 {
constexpr int BM = 256, BK = 64, HALF = 128, HTB = HALF * BK * 2, NXCD = 8, WGM = 8;
__device__ __forceinline__ int lds_byte(int r, int c) { const int st = (r >> 4) * 2 + (c >> 5), rr = r & 15, cc = c & 31, ob = rr * 64 + cc * 2; return st * 1024 + (ob ^ (((ob >> 9) & 1) << 5)); }
__device__ __forceinline__ void stage_rc(int b, int& R, int& C) { const int st = b / 1024, sb = b % 1024, swz = sb ^ (((sb >> 9) & 1) << 5); R = (st >> 1) * 16 + swz / 64; C = (st & 1) * 32 + (swz % 64) / 2; }
__device__ __forceinline__ int perm32(int rho) { const int n = rho >> 4, i = rho & 15; return 8 * (i >> 2) + 4 * n + (i & 3); }

struct Unit { const char* A; const char* B; int nt; int pm; int pn; int kind; };

struct Sched {
    int nM, nN, nwg, G, c, parts, mt0, has_meta, nt0, nt1, pn_base, pn_last;
    const char *Ax, *Am, *B; size_t a_tile, b_tile, a_part1;
    __device__ bool next(int j, Unit& u) const {
        const int i = parts == 2 ? (j >> 1) : j, part = parts == 2 ? (j & 1) : 0;
        const long L = (long)i * G + c; if (L >= nwg) return false;
        int wgid = (int)L; { const int q = nwg / NXCD, r = nwg % NXCD, xcd = wgid % NXCD, off = wgid / NXCD; wgid = (xcd < r ? xcd * (q + 1) : r * (q + 1) + (xcd - r) * q) + off; }
        const int nig = WGM * nN, gid = wgid / nig, fm = gid * WGM, gsz = (nM - fm) < WGM ? (nM - fm) : WGM;
        const int pml = fm + ((wgid % nig) % gsz), pn = (wgid % nig) / gsz;
        const bool meta = has_meta && pml == nM - 1;
        const int pna = (pn_last >= 0 && pn == nN - 1) ? pn_last : pn_base + pn;
        u.pm = meta ? META_TILE : mt0 + pml; u.pn = pna;
        const size_t ko = part ? (size_t)nt0 * (BK * 2) : 0;
        u.A = (meta ? Am : Ax + (size_t)pml * a_tile) + (part ? a_part1 : 0); u.B = B + (size_t)pna * b_tile + ko;
        u.nt = part ? nt1 : nt0; u.kind = parts == 2 ? part + 1 : 0;
        return true;
    }
};

template <class Epi>
__device__ __forceinline__ void gemm_phase(LAS unsigned char* lds, const int lda, const int ldb, const Sched& S, const Epi& E) {
    const int tid = otid(), wid = __builtin_amdgcn_readfirstlane(tid >> 6), lane = tid & 63, wr = wid >> 2, wc = wid & 3, fr = lane & 15, fq = lane >> 4;
    unsigned voffA[2], voffB[2];
#pragma unroll
    for (int i = 0; i < 2; ++i) { int R, C; stage_rc(tid * 16 + i * 8192, R, C); const int Rb = (R & ~31) + perm32(R & 31);
        voffA[i] = (unsigned)(R * lda + C) * 2u; voffB[i] = (unsigned)(Rb * ldb + C) * 2u; }
    const size_t kstep = (size_t)(BK * 2);
    const size_t hstepA = (size_t)HALF * lda * 2, hstepB = (size_t)HALF * ldb * 2;
    const unsigned ldsw = (unsigned)wid * 1024u;
    const int aoff = lds_byte(wr * 64 + fr, fq * 8), boff = lds_byte(wc * 32 + fr, fq * 8);
#define PG8_SA(b, h) (((b) * 2 + (h)) * HTB)
#define PG8_SB(b, h) ((4 + (b) * 2 + (h)) * HTB)
#define PG8_STAGE(bufoff, gbase, voff) do { _Pragma("unroll") for (int _i = 0; _i < 2; ++_i) \
        __builtin_amdgcn_global_load_lds((const unsigned*)((const char*)(gbase) + (voff)[_i]), (LAS unsigned*)(lds + (bufoff) + ldsw + _i * 8192), 16, 0, 0); } while (0)
#define PG8_LDA(dst, b, h) do { _Pragma("unroll") for (int m = 0; m < 4; ++m) _Pragma("unroll") for (int k = 0; k < 2; ++k) dst[m][k] = *(const LAS bf16x8*)(lds + PG8_SA(b, h) + aoff + m * 2048 + k * 1024); } while (0)
#define PG8_LDB(dst, b, h) do { _Pragma("unroll") for (int n = 0; n < 2; ++n) _Pragma("unroll") for (int k = 0; k < 2; ++k) dst[n][k] = *(const LAS bf16x8*)(lds + PG8_SB(b, h) + boff + n * 2048 + k * 1024); } while (0)
#define PG8_MMA(ai, bj, At, Bt) do { __builtin_amdgcn_s_setprio(1); _Pragma("unroll") for (int m = 0; m < 4; ++m) _Pragma("unroll") for (int n = 0; n < 2; ++n) _Pragma("unroll") for (int k = 0; k < 2; ++k) \
        acc[ai][bj][m][n] = __builtin_amdgcn_mfma_f32_16x16x32_bf16(Bt[n][k], At[m][k], acc[ai][bj][m][n], 0, 0, 0); __builtin_amdgcn_s_setprio(0); } while (0)
#define PG8_WAIT_V(n) asm volatile("s_waitcnt vmcnt(" #n ")" ::: "memory")
#define PG8_WAIT_L(n) asm volatile("s_waitcnt lgkmcnt(" #n ")" ::: "memory")
#define PG8_BAR __builtin_amdgcn_s_barrier()
#define PG8_SCHED __builtin_amdgcn_sched_barrier(0)
    Unit cur, nxt; int ui = 0;
    if (!S.next(0, cur)) return;
    f32x4 acc[2][2][4][2];
#pragma unroll
    for (int a = 0; a < 2; ++a)
#pragma unroll
        for (int b = 0; b < 2; ++b)
#pragma unroll
            for (int m = 0; m < 4; ++m)
#pragma unroll
                for (int n = 0; n < 2; ++n) acc[a][b][m][n] = (f32x4){0.f, 0.f, 0.f, 0.f};
    bf16x8 At[4][2], B0[2][2], B1[2][2];
    const char* cA = cur.A; const char* cB = cur.B;
    PG8_STAGE(PG8_SB(0, 0), cB, voffB); PG8_STAGE(PG8_SA(0, 0), cA, voffA); PG8_STAGE(PG8_SB(0, 1), cB + hstepB, voffB); PG8_STAGE(PG8_SA(0, 1), cA + hstepA, voffA);
    if (wr == 1) PG8_BAR;
    PG8_WAIT_V(4); PG8_BAR;
    PG8_STAGE(PG8_SB(1, 0), cB + kstep, voffB); PG8_STAGE(PG8_SA(1, 0), cA + kstep, voffA); PG8_STAGE(PG8_SB(1, 1), cB + hstepB + kstep, voffB);
    PG8_WAIT_V(6); PG8_BAR;
    for (;;) {
        const bool has_next = S.next(ui + 1, nxt);
        const char* nA = has_next ? nxt.A : cA; const char* nB = has_next ? nxt.B : cB;
        const int nt = cur.nt;
        for (int t = 0; t < nt; t += 2) {
            const bool last = (t == nt - 2);
            const char* a1 = cA + (size_t)(t + 1) * kstep;
            const char* a2 = last ? nA : cA + (size_t)(t + 2) * kstep; const char* b2 = last ? nB : cB + (size_t)(t + 2) * kstep;
            const char* a3 = a2 + kstep; const char* b3 = b2 + kstep;
            PG8_LDB(B0, 0, 0); PG8_SCHED; PG8_LDA(At, 0, 0); PG8_STAGE(PG8_SA(1, 1), a1 + hstepA, voffA);
            PG8_WAIT_L(8); PG8_BAR; PG8_WAIT_L(0); PG8_MMA(0, 0, At, B0); PG8_BAR; PG8_SCHED;
            PG8_LDB(B1, 0, 1); PG8_STAGE(PG8_SB(0, 0), b2, voffB);
            PG8_BAR; PG8_WAIT_L(0); PG8_MMA(0, 1, At, B1); PG8_BAR;
            PG8_LDA(At, 0, 1); PG8_STAGE(PG8_SA(0, 0), a2, voffA);
            PG8_BAR; PG8_WAIT_L(0); PG8_MMA(1, 0, At, B0); PG8_BAR; PG8_SCHED;
            PG8_STAGE(PG8_SB(0, 1), b2 + hstepB, voffB);
            PG8_WAIT_V(6); PG8_BAR; PG8_MMA(1, 1, At, B1); PG8_BAR;
            PG8_LDB(B0, 1, 0); PG8_SCHED; PG8_LDA(At, 1, 0); PG8_STAGE(PG8_SA(0, 1), a2 + hstepA, voffA);
            PG8_WAIT_L(8); PG8_BAR; PG8_WAIT_L(0); PG8_MMA(0, 0, At, B0); PG8_BAR; PG8_SCHED;
            PG8_LDB(B1, 1, 1); PG8_STAGE(PG8_SB(1, 0), b3, voffB);
            PG8_BAR; PG8_WAIT_L(0); PG8_MMA(0, 1, At, B1); PG8_BAR;
            PG8_LDA(At, 1, 1); PG8_STAGE(PG8_SA(1, 0), a3, voffA);
            PG8_BAR; PG8_WAIT_L(0); PG8_MMA(1, 0, At, B0); PG8_BAR; PG8_SCHED;
            PG8_STAGE(PG8_SB(1, 1), b3 + hstepB, voffB);
            PG8_WAIT_V(6); PG8_BAR; PG8_MMA(1, 1, At, B1); PG8_BAR;
        }
        E(acc, cur, wr, wc, fr, fq);
        if (!has_next) break;
        if (cur.kind != 1) {
#pragma unroll
            for (int a = 0; a < 2; ++a)
#pragma unroll
                for (int b = 0; b < 2; ++b)
#pragma unroll
                    for (int m = 0; m < 4; ++m)
#pragma unroll
                        for (int n = 0; n < 2; ++n) acc[a][b][m][n] = (f32x4){0.f, 0.f, 0.f, 0.f};
        }
        cur = nxt; cA = nA; cB = nB; ++ui;
    }
    PG8_WAIT_V(0);
    if (wr == 0) PG8_BAR;
    PG8_BAR;
#undef PG8_SA
#undef PG8_SB
#undef PG8_STAGE
#undef PG8_LDA
#undef PG8_LDB
#undef PG8_MMA
#undef PG8_WAIT_V
#undef PG8_WAIT_L
#undef PG8_BAR
#undef PG8_SCHED
}
}
using pg8::Unit;
typedef f32x4 Acc[2][2][4][2];

__device__ __forceinline__ float dpp_prev1(float cur, float prev) {
    const int o = __builtin_amdgcn_mov_dpp(__builtin_bit_cast(int, prev), 0x121, 0xf, 0xf, false);
    return __builtin_bit_cast(float, __builtin_amdgcn_update_dpp(o, __builtin_bit_cast(int, cur), 0x111, 0xf, 0xf, false));
}
__device__ __forceinline__ float dpp_prev2(float cur, float prev) {
    const int o = __builtin_amdgcn_mov_dpp(__builtin_bit_cast(int, prev), 0x122, 0xf, 0xf, false);
    return __builtin_bit_cast(float, __builtin_amdgcn_update_dpp(o, __builtin_bit_cast(int, cur), 0x112, 0xf, 0xf, false));
}
__device__ __forceinline__ float dpp_prev3(float cur, float prev) {
    const int o = __builtin_amdgcn_mov_dpp(__builtin_bit_cast(int, prev), 0x123, 0xf, 0xf, false);
    return __builtin_bit_cast(float, __builtin_amdgcn_update_dpp(o, __builtin_bit_cast(int, cur), 0x113, 0xf, 0xf, false));
}
struct EpiG1 {
    unsigned char* ws; const float* dt_bias; const float* cw; const float* cb;
    __device__ __forceinline__ void operator()(Acc& acc, const Unit& u, int wr, int wc, int fr, int fq) const {
        if (u.pn >= 8 && u.pn < 20) {
#pragma unroll
            for (int bj = 0; bj < 2; ++bj) {
                const int ch = 256 * (u.pn - 8) + 128 * bj + 32 * wc + 8 * fq;
                float wv[5][8];
#pragma unroll
                for (int h = 0; h < 2; ++h) { const f32x4 b0 = *(const f32x4*)(cb + ch + 4 * h);
#pragma unroll
                    for (int j = 0; j < 4; ++j) wv[4][4 * h + j] = b0[j];
#pragma unroll
                    for (int k = 0; k < 4; ++k) { const f32x4 a0 = *(const f32x4*)(cw + k * 3072 + ch + 4 * h);
#pragma unroll
                        for (int j = 0; j < 4; ++j) wv[k][4 * h + j] = a0[j]; } }
#pragma unroll
                for (int ai = 0; ai < 2; ++ai)
#pragma unroll
                    for (int m = 0; m < 4; ++m) {
                        const int lr = 128 * ai + 64 * wr + 16 * m + fr, grow = u.pm * 256 + lr;
                        float o[8], rw[8];
#pragma unroll
                        for (int j = 0; j < 8; ++j) { const float c0 = acc[ai][bj][m][j >> 2][j & 3], pv = acc[ai][bj][m > 0 ? m - 1 : 0][j >> 2][j & 3];
                            const float v = wv[4][j] + wv[3][j] * c0 + wv[2][j] * dpp_prev1(c0, pv) + wv[1][j] * dpp_prev2(c0, pv) + wv[0][j] * dpp_prev3(c0, pv);
                            o[j] = silu_f(v); rw[j] = c0; }
                        *(u32x4*)((bf16_t*)(ws + OFF_PROJ) + (size_t)grow * PROJ_LD + C_XS + ch) = pack8(o);
                        if (m == 0 || m == 3) {
                            const bool top = m == 0 && fr < 3, bot = m == 3 && fr >= 13;
                            if (top || bot) *(u32x4*)((bf16_t*)(ws + OFF_RAW1) + (size_t)((grow >> 6) * 6 + (top ? 3 + fr : fr - 13)) * 3072 + ch) = pack8(rw);
                            if (m == 0 && u.pm == META_TILE && ai == 0 && wr == 0 && fr >= 13) *(u32x4*)((bf16_t*)(ws + OFF_RAW1M) + (size_t)(fr - 13) * 3072 + ch) = pack8(rw);
                        }
                    }
            }
            return;
        }
#pragma unroll
        for (int ai = 0; ai < 2; ++ai)
#pragma unroll
            for (int m = 0; m < 4; ++m) {
                const int lr = 128 * ai + 64 * wr + 16 * m + fr;
                if (u.pn < 34) {
                    bf16_t* rp = (bf16_t*)(ws + OFF_PROJ) + (size_t)(u.pm * 256 + lr) * PROJ_LD + (u.pn < 26 ? 256 * u.pn : C_GS + 256 * (u.pn - 26)) + 32 * wc + 8 * fq;
#pragma unroll
                    for (int bj = 0; bj < 2; ++bj) { u32x4 o; o.x = cvt_pk_bf16(acc[ai][bj][m][0][0], acc[ai][bj][m][0][1]); o.y = cvt_pk_bf16(acc[ai][bj][m][0][2], acc[ai][bj][m][0][3]);
                        o.z = cvt_pk_bf16(acc[ai][bj][m][1][0], acc[ai][bj][m][1][1]); o.w = cvt_pk_bf16(acc[ai][bj][m][1][2], acc[ai][bj][m][1][3]); *(u32x4*)(rp + 128 * bj) = o;
 }
                } else if (wc == 0) {
                    float* dp = (float*)(ws + OFF_DT) + (size_t)(u.pm * 256 + lr) * 32 + 8 * fq;
                    f32x4 d0, d1;
#pragma unroll
                    for (int j = 0; j < 4; ++j) { const float x0 = acc[ai][0][m][0][j] + dt_bias[8 * fq + j], x1 = acc[ai][0][m][1][j] + dt_bias[8 * fq + 4 + j];
                        d0[j] = fmaxf(x0, 0.f) + __logf(1.f + __expf(-fabsf(x0))); d1[j] = fmaxf(x1, 0.f) + __logf(1.f + __expf(-fabsf(x1))); }
                    *(f32x4*)dp = d0; *(f32x4*)(dp + 4) = d1;
                }
            }
    }
};
struct EpiG2 {
    unsigned char* ws; bf16_t* mbuf_x;
    __device__ __forceinline__ void operator()(Acc& acc, const Unit& u, int wr, int wc, int fr, int fq) const {
#pragma unroll
        for (int ai = 0; ai < 2; ++ai)
#pragma unroll
            for (int m = 0; m < 4; ++m) {
                const int lr = 128 * ai + 64 * wr + 16 * m + fr, grow = u.pm * 256 + lr, c8 = 256 * u.pn + 32 * wc + 8 * fq;
                const bf16_t* pr = proj_row(ws, grow);
                if (u.kind == 1) {
                    const f32x4* sq = (const f32x4*)((const float*)(ws + OFF_SSQ) + (size_t)grow * 32);
                    float s = 0.f;
#pragma unroll
                    for (int i = 0; i < 8; ++i) { const f32x4 v = sq[i]; s += (v[0] + v[1]) + (v[2] + v[3]); }
                    const float rs = rsqrtf(s * (1.f / 2048.f) + EPS);
#pragma unroll
                    for (int bj = 0; bj < 2; ++bj) {
                        float gs[8], ga[8]; unpack8(*(const u32x4*)(pr + C_GS + c8 + 128 * bj), gs); unpack8(*(const u32x4*)(pr + C_GA + c8 + 128 * bj), ga);
#pragma unroll
                        for (int j = 0; j < 8; ++j) { const float a = fminf(fmaxf(ga[j], -60.f), 60.f), g = fminf(fmaxf(gs[j], -60.f), 60.f);
                            acc[ai][bj][m][j >> 2][j & 3] *= rs * (1.f + __expf(-a)) * __builtin_amdgcn_rcpf(1.f + __expf(-g)); }
                    }
                } else {
                    bf16_t* op = (u.pm == META_TILE ? (bf16_t*)(ws + OFF_MBUF_META) + (size_t)lr * D : mbuf_x + (size_t)grow * D) + c8;
#pragma unroll
                    for (int bj = 0; bj < 2; ++bj) {
                        float ga[8], o[8]; unpack8(*(const u32x4*)(pr + C_GA + c8 + 128 * bj), ga);
#pragma unroll
                        for (int j = 0; j < 8; ++j) { const float a = fminf(fmaxf(ga[j], -60.f), 60.f); o[j] = acc[ai][bj][m][j >> 2][j & 3] * __builtin_amdgcn_rcpf(1.f + __expf(-a)); }
                        *(u32x4*)(op + 128 * bj) = pack8(o);
                    }
                }
            }
    }
};
struct EpiF32 {
    float* C;
    __device__ __forceinline__ void operator()(Acc& acc, const Unit& u, int wr, int wc, int fr, int fq) const {
#pragma unroll
        for (int ai = 0; ai < 2; ++ai)
#pragma unroll
            for (int m = 0; m < 4; ++m) {
                float* rp = C + (size_t)(u.pm * 256 + 128 * ai + 64 * wr + 16 * m + fr) * D + 256 * u.pn + 32 * wc + 8 * fq;
#pragma unroll
                for (int bj = 0; bj < 2; ++bj) { *(f32x4*)(rp + 128 * bj) = acc[ai][bj][m][0]; *(f32x4*)(rp + 128 * bj + 4) = acc[ai][bj][m][1]; }
            }
    }
};
struct EpiB16 {
    bf16_t* C;
    __device__ __forceinline__ void operator()(Acc& acc, const Unit& u, int wr, int wc, int fr, int fq) const {
#pragma unroll
        for (int ai = 0; ai < 2; ++ai)
#pragma unroll
            for (int m = 0; m < 4; ++m) {
                bf16_t* rp = C + (size_t)(u.pm * 256 + 128 * ai + 64 * wr + 16 * m + fr) * D + 256 * u.pn + 32 * wc + 8 * fq;
#pragma unroll
                for (int bj = 0; bj < 2; ++bj) { u32x4 o; o.x = cvt_pk_bf16(acc[ai][bj][m][0][0], acc[ai][bj][m][0][1]); o.y = cvt_pk_bf16(acc[ai][bj][m][0][2], acc[ai][bj][m][0][3]);
                    o.z = cvt_pk_bf16(acc[ai][bj][m][1][0], acc[ai][bj][m][1][1]); o.w = cvt_pk_bf16(acc[ai][bj][m][1][2], acc[ai][bj][m][1][3]); *(u32x4*)(rp + 128 * bj) = o; }
            }
    }
};
struct EpiG4F {
    bf16_t* act; bf16_t* raw; const float* cw; const float* cb;
    __device__ __forceinline__ void operator()(Acc& acc, const Unit& u, int wr, int wc, int fr, int fq) const {
        const int c8 = 128 * u.pn + 32 * wc + 8 * fq;
        float wa[3][8], wg[3][8], ba[8], bg[8];
#pragma unroll
        for (int h = 0; h < 2; ++h) {
            const f32x4 b0 = *(const f32x4*)(cb + c8 + 4 * h), b1 = *(const f32x4*)(cb + FF + c8 + 4 * h);
#pragma unroll
            for (int j = 0; j < 4; ++j) { ba[4 * h + j] = b0[j]; bg[4 * h + j] = b1[j]; }
#pragma unroll
            for (int k = 0; k < 3; ++k) { const f32x4 a0 = *(const f32x4*)(cw + k * U_LD + c8 + 4 * h), g0 = *(const f32x4*)(cw + k * U_LD + FF + c8 + 4 * h);
#pragma unroll
                for (int j = 0; j < 4; ++j) { wa[k][4 * h + j] = a0[j]; wg[k][4 * h + j] = g0[j]; } }
        }
#pragma unroll
        for (int ai = 0; ai < 2; ++ai)
#pragma unroll
            for (int m = 0; m < 4; ++m) {
                const int lr = 128 * ai + 64 * wr + 16 * m + fr, grow = u.pm * 256 + lr;
                float o[8], ra[8], rg[8];
#pragma unroll
                for (int j = 0; j < 8; ++j) {
                    const float ca = acc[ai][0][m][j >> 2][j & 3], cg = acc[ai][1][m][j >> 2][j & 3];
                    const float pa = acc[ai][0][m > 0 ? m - 1 : 0][j >> 2][j & 3], pg = acc[ai][1][m > 0 ? m - 1 : 0][j >> 2][j & 3];
                    const float a1 = dpp_prev1(ca, pa), a2 = dpp_prev2(ca, pa), g1 = dpp_prev1(cg, pg), g2 = dpp_prev2(cg, pg);
                    const float va = ba[j] + wa[2][j] * ca + wa[1][j] * a1 + wa[0][j] * a2;
                    const float vg = bg[j] + wg[2][j] * cg + wg[1][j] * g1 + wg[0][j] * g2;
                    o[j] = silu_f(va) * vg; ra[j] = ca; rg[j] = cg;
                }
                *(u32x4*)(act + (size_t)grow * FF + c8) = pack8(o);
                if (m == 0 || m == 3) {
                    const bool top = m == 0 && fr < 2, bot = m == 3 && fr >= 14;
                    if (top || bot) { bf16_t* rp = raw + (size_t)((grow >> 6) * 4 + (top ? 2 + fr : fr - 14)) * U_LD + c8;
                        *(u32x4*)rp = pack8(ra); *(u32x4*)(rp + FF) = pack8(rg); }
                }
            }
    }
};
__device__ __forceinline__ void ffn_fixup(const Params& p, int pm) {
    const int t = otid();
    bf16_t* act = (bf16_t*)(p.ws + OFF_U); const bf16_t* raw = (const bf16_t*)(p.ws + OFF_RAW); const bf16_t* rawm = (const bf16_t*)(p.ws + OFF_RAWM);
    const float* cw = p.in[17]; const float* cb = p.in[18];
    for (int task = t; task < 4 * 352; task += 512) {
        const int q = task / 352, c = (task % 352) * 8, g = pm * 4 + q, R = g * 64;
        const bf16_t* cur = raw + (size_t)(g * 4 + 2) * U_LD;
        const bf16_t* prv = (R & 4095) == 0 ? rawm : raw + (size_t)((g - 1) * 4) * U_LD;
        float a[4][8], gg[4][8];
        unpack8(*(const u32x4*)(prv + c), a[0]); unpack8(*(const u32x4*)(prv + U_LD + c), a[1]); unpack8(*(const u32x4*)(cur + c), a[2]); unpack8(*(const u32x4*)(cur + U_LD + c), a[3]);
        unpack8(*(const u32x4*)(prv + FF + c), gg[0]); unpack8(*(const u32x4*)(prv + U_LD + FF + c), gg[1]); unpack8(*(const u32x4*)(cur + FF + c), gg[2]); unpack8(*(const u32x4*)(cur + U_LD + FF + c), gg[3]);
#pragma unroll
        for (int i = 0; i < 2; ++i) { float o[8];
#pragma unroll
            for (int j = 0; j < 8; ++j) {
                const float va = cb[c + j] + cw[2 * U_LD + c + j] * a[i + 2][j] + cw[U_LD + c + j] * a[i + 1][j] + cw[c + j] * a[i][j];
                const float vg = cb[FF + c + j] + cw[2 * U_LD + FF + c + j] * gg[i + 2][j] + cw[U_LD + FF + c + j] * gg[i + 1][j] + cw[FF + c + j] * gg[i][j];
                o[j] = silu_f(va) * vg; }
            *(u32x4*)(act + (size_t)(R + i) * FF + c) = pack8(o); }
    }
}
struct EpiG4 {
    bf16_t* U; bf16_t* halo;
    __device__ __forceinline__ void operator()(Acc& acc, const Unit& u, int wr, int wc, int fr, int fq) const {
#pragma unroll
        for (int ai = 0; ai < 2; ++ai)
#pragma unroll
            for (int m = 0; m < 4; ++m) {
                const int lr = 128 * ai + 64 * wr + 16 * m + fr, col = 256 * u.pn + 32 * wc + 8 * fq;
                bf16_t* rp = U + (size_t)(u.pm * 256 + lr) * U_LD + col;
                const bool h = (u.pm == META_TILE) ? (lr == 14 || lr == 15) : (lr >= 254);
                bf16_t* hp = halo + (size_t)(u.pm * 2 + (lr & 1)) * U_LD + col;
#pragma unroll
                for (int bj = 0; bj < 2; ++bj) { u32x4 o; o.x = cvt_pk_bf16(acc[ai][bj][m][0][0], acc[ai][bj][m][0][1]); o.y = cvt_pk_bf16(acc[ai][bj][m][0][2], acc[ai][bj][m][0][3]);
                    o.z = cvt_pk_bf16(acc[ai][bj][m][1][0], acc[ai][bj][m][1][1]); o.w = cvt_pk_bf16(acc[ai][bj][m][1][2], acc[ai][bj][m][1][3]); *(u32x4*)(rp + 128 * bj) = o;
                    if (h) *(u32x4*)(hp + 128 * bj) = o; }
            }
    }
};

__device__ __forceinline__ void tr_item(const float* W, int ldn, int k0, int n0src, bool zero, const float* kscale, bf16_t* WT, int ldk, int nrow0, int kcol0, LAS float* scr, int lane) {
#pragma unroll
    for (int i = 0; i < 32; ++i) { const int kk = 2 * i + (lane >> 5); float v = zero ? 0.f : __builtin_nontemporal_load(W + (size_t)(k0 + kk) * ldn + n0src + (lane & 31)); if (kscale) v *= kscale[k0 + kk]; scr[kk * 33 + (lane & 31)] = v; }
    asm volatile("s_waitcnt lgkmcnt(0)" ::: "memory");
    const int c = lane & 7;
#pragma unroll
    for (int j = 0; j < 4; ++j) { const int n = (lane >> 3) + 8 * j; const LAS float* s = scr + (8 * c) * 33 + n;
        u32x4 o; o.x = cvt_pk_bf16(s[0 * 33], s[1 * 33]); o.y = cvt_pk_bf16(s[2 * 33], s[3 * 33]); o.z = cvt_pk_bf16(s[4 * 33], s[5 * 33]); o.w = cvt_pk_bf16(s[6 * 33], s[7 * 33]);
        *(u32x4*)(WT + (size_t)(nrow0 + n) * ldk + kcol0 + k0 + 8 * c) = o; }
    asm volatile("s_waitcnt lgkmcnt(0)" ::: "memory");
}
__device__ __forceinline__ void phase_prep(const Params& p, LAS unsigned char* lds) {
    const int tid_ = otid(), lane = tid_ & 63, wave = tid_ >> 6, gw = obid() * 8 + wave, NGW = gridDim.x * 8;
    LAS float* scr = (LAS float*)(lds + wave * 8448);
    constexpr int I_IN = 280 * 16, I_SSM = 32 * 32, I_AT = 16 * 32, I_MIX = 16 * 32, I_UP = 16 * 176, I_DN = 44 * 32;
    constexpr int NIT = I_IN + I_SSM + I_AT + I_MIX + I_UP + I_DN;
    for (int it = gw; it < NIT; it += NGW) {
        int r = it;
        if (r < I_IN) { const int nb = r % 280, kb = r / 280; const int srcb = nb < 160 ? nb : (nb < 272 ? nb + 1 : 160);
            tr_item(p.in[3], 8736, 64 * kb, 32 * srcb, nb > 272, nullptr, (bf16_t*)(p.ws + OFF_WIN), 1024, 32 * nb, 0, scr, lane); continue; } r -= I_IN;
        if (r < I_SSM) { const int nb = r % 32, kb = r / 32; tr_item(p.in[10], 1024, 64 * kb, 32 * nb, false, p.in[9], (bf16_t*)(p.ws + OFF_WG2), 3072, 32 * nb, 0, scr, lane); continue; } r -= I_SSM;
        if (r < I_AT) { const int nb = r % 32, kb = r / 32; tr_item(p.in[12], 1024, 64 * kb, 32 * nb, false, nullptr, (bf16_t*)(p.ws + OFF_WG2), 3072, 32 * nb, 2048, scr, lane); continue; } r -= I_AT;
        if (r < I_MIX) { const int nb = r % 32, kb = r / 32; tr_item(p.in[13], 1024, 64 * kb, 32 * nb, false, nullptr, (bf16_t*)(p.ws + OFF_WMIX), 1024, 32 * nb, 0, scr, lane); continue; } r -= I_MIX;
        if (r < I_UP) { const int nb = r % 176, kb = r / 176; const int srcc = ((nb & 4) ? FF : 0) + 128 * (nb >> 3) + 32 * (nb & 3);
            tr_item(p.in[16], 5632, 64 * kb, srcc, false, nullptr, (bf16_t*)(p.ws + OFF_WUP), 1024, 32 * nb, 0, scr, lane); continue; } r -= I_UP;
        { const int nb = r % 32, kb = r / 32; tr_item(p.in[19], 1024, 64 * kb, 32 * nb, false, nullptr, (bf16_t*)(p.ws + OFF_WDN), 2816, 32 * nb, 0, scr, lane); }
    }
    const float* w = p.in[2];
    f32x4 wv[4];
#pragma unroll
    for (int j = 0; j < 4; ++j) wv[j] = *(const f32x4*)(w + (lane + 64 * j) * 4);
    for (int r0 = gw; r0 < MROWS; r0 += 4 * NGW) {
        f32x4 v[4][4];
#pragma unroll
        for (int i = 0; i < 4; ++i) { const int r = r0 + i * NGW; const bool real = r < XROWS + NMETA;
            const float* src = r < XROWS ? p.in[0] + (size_t)r * D : p.in[1] + (size_t)(real ? r - XROWS : 0) * D;
#pragma unroll
            for (int j = 0; j < 4; ++j) v[i][j] = __builtin_nontemporal_load((const f32x4*)(src + (lane + 64 * j) * 4)); }
#pragma unroll
        for (int i = 0; i < 4; ++i) { const int r = r0 + i * NGW;
            if (r >= MROWS) continue;
            const bool real = r < XROWS + NMETA;
            bf16_t* dst = r < XROWS ? (bf16_t*)p.out + (size_t)r * D : (bf16_t*)(p.ws + OFF_HN_META) + (size_t)(r - XROWS) * D;
            float s = 0.f;
#pragma unroll
            for (int j = 0; j < 4; ++j) s += (v[i][j][0] * v[i][j][0] + v[i][j][1] * v[i][j][1]) + (v[i][j][2] * v[i][j][2] + v[i][j][3] * v[i][j][3]);
            const float rs = real ? rsqrtf(wave_sum(s) * (1.f / D) + EPS) : 0.f;
#pragma unroll
            for (int j = 0; j < 4; ++j) { u32x2 o; o.x = cvt_pk_bf16(v[i][j][0] * rs * wv[j][0], v[i][j][1] * rs * wv[j][1]); o.y = cvt_pk_bf16(v[i][j][2] * rs * wv[j][2], v[i][j][3] * rs * wv[j][3]);
                *(u32x2*)(dst + (lane + 64 * j) * 4) = o; }
        }
    }
}

__device__ __forceinline__ unsigned bf_pair(unsigned x, unsigned y, int j) { const unsigned a = (j & 1) ? (x >> 16) : (x & 0xffffu), c = (j & 1) ? (y & 0xffff0000u) : (y << 16); return a | c; }
__device__ __forceinline__ int ssd_pos(int c, int tk) { return c == 0 ? tk - 48 : 16 + (c - 1) * 64 + tk; }
__device__ __forceinline__ void ssd_load4(const unsigned char* ws, int b, int c, int tg, int col, u32x4 (&raw)[4]) {
#pragma unroll
    for (int k = 0; k < 4; ++k) { const int pos = ssd_pos(c, 4 * tg + k);
        const u32x4 v = *(const u32x4*)(proj_row(ws, rowof(b, pos < 0 ? 0 : pos)) + col); const unsigned m = pos >= 0 ? 0xffffffffu : 0u;
        raw[k] = (u32x4){v.x & m, v.y & m, v.z & m, v.w & m}; }
}
__device__ __forceinline__ void ssd_load2(const unsigned char* ws, int b, int c, int tp, int col, u32x2 (&raw)[2]) {
#pragma unroll
    for (int k = 0; k < 2; ++k) { const int pos = ssd_pos(c, 2 * tp + k);
        const u32x2 v = *(const u32x2*)(proj_row(ws, rowof(b, pos < 0 ? 0 : pos)) + col); const unsigned m = pos >= 0 ? 0xffffffffu : 0u;
        raw[k] = (u32x2){v.x & m, v.y & m}; }
}
__device__ __forceinline__ float ssd_loaddt(const unsigned char* ws, int b, int c, int lane, int head) {
    const int pos = ssd_pos(c, lane); return ((const float*)(ws + OFF_DT))[(size_t)rowof(b, pos < 0 ? 0 : pos) * 32 + head];
}
#define FRAG(base, stride, row, kel) (*(const LAS bf16x8*)((base) + (row) * (stride) + (kel) * 2))
__device__ __forceinline__ void ssm_fixup(const Params& p, int b, int head) {
    unsigned char* ws = p.ws;
    const int t = otid(), grp = head >> 3;
    const bf16_t* raw = (const bf16_t*)(ws + OFF_RAW1); const bf16_t* rawm = (const bf16_t*)(ws + OFF_RAW1M);
    const float* cw = p.in[4]; const float* cb = p.in[5];
    for (int task = t; task < 65 * 40; task += 512) {
        const int q = task / 40, cgp = task % 40, g = q < 64 ? b * 64 + q : 512;
        const int ch = cgp < 8 ? head * 64 + cgp * 8 : (cgp < 24 ? 2048 + grp * 128 + (cgp - 8) * 8 : 2560 + grp * 128 + (cgp - 24) * 8);
        float u[6][8];
        const bool zero_prev = g == 512, from_meta = !zero_prev && (g & 63) == 0;
        const bf16_t* prv = from_meta ? rawm : raw + (size_t)((zero_prev ? g : g - 1) * 6) * 3072;
#pragma unroll
        for (int k = 0; k < 3; ++k) { unpack8(*(const u32x4*)(prv + (size_t)k * 3072 + ch), u[k]);
            if (zero_prev) {
#pragma unroll
                for (int j = 0; j < 8; ++j) u[k][j] = 0.f; } }
#pragma unroll
        for (int k = 0; k < 3; ++k) unpack8(*(const u32x4*)(raw + (size_t)(g * 6 + 3 + k) * 3072 + ch), u[3 + k]);
        float wv[5][8];
#pragma unroll
        for (int h = 0; h < 2; ++h) { const f32x4 b0 = *(const f32x4*)(cb + ch + 4 * h);
#pragma unroll
            for (int j = 0; j < 4; ++j) wv[4][4 * h + j] = b0[j];
#pragma unroll
            for (int k = 0; k < 4; ++k) { const f32x4 a0 = *(const f32x4*)(cw + k * 3072 + ch + 4 * h);
#pragma unroll
                for (int j = 0; j < 4; ++j) wv[k][4 * h + j] = a0[j]; } }
#pragma unroll
        for (int i = 0; i < 3; ++i) { float o[8];
#pragma unroll
            for (int j = 0; j < 8; ++j) { float v = wv[4][j];
#pragma unroll
                for (int k = 0; k < 4; ++k) v += wv[k][j] * u[i + k][j];
                o[j] = silu_f(v); }
            *(u32x4*)((bf16_t*)(ws + OFF_PROJ) + (size_t)(g * 64 + i) * PROJ_LD + C_XS + ch) = pack8(o); }
    }
    asm volatile("s_waitcnt vmcnt(0)" ::: "memory");
}
__device__ __forceinline__ void ssd_item(const Params& p, LAS unsigned char* lds, int b, int head) {
    ssm_fixup(p, b, head);
    unsigned char* ws = p.ws;
    const int tq = otid(), w = __builtin_amdgcn_readfirstlane(tq >> 6), grp = head >> 3, wp = w & 3, wl = w >> 2;
    LAS unsigned char* C_rm = lds;
    LAS unsigned char* B_rm = lds + 17408;
    LAS unsigned char* h_bf = lds + 34816;
    LAS unsigned char* BT = lds + 52224;
    LAS unsigned char* xdtT = lds + 70656;
    LAS unsigned char* M_s = lds + 79872;
    LAS unsigned char* xs_rm = lds + 89088;
    LAS unsigned char* xdtwT = lds + 98304;
    LAS float* dt_s2 = (LAS float*)(lds + 107520);
    LAS float* cs_s2 = dt_s2 + 128;
    LAS float* ssq_s = cs_s2 + 128;
    LAS float* cw_s = ssq_s + 256;
    const float Aneg = -__expf(p.in[7][head]), Dsk = p.in[8][head];
    __syncthreads();
    for (int i = tq; i < 17408 / 4; i += 512) ((LAS unsigned*)h_bf)[i] = 0u;
#ifndef SSD_RELAUNDER
#define SSD_RELAUNDER 0
#endif
#if SSD_RELAUNDER
#define SSD_LAUNDER(v) asm volatile("" : "+v"(v));
#else
#define SSD_LAUNDER(v)
#endif
#define SSD_LANE_VARS(tsrc) \
    int t = (tsrc); SSD_LAUNDER(t) \
    const int lane = t & 63, fr = lane & 15, fq = lane >> 4; \
    const bool isB = t < 256; const int t0 = isB ? t : t - 256, tg0 = t0 >> 4, cg0 = t0 & 15; \
    const int col0 = C_XS + (isB ? 2048 : 2560) + grp * 128 + 8 * cg0; \
    const int tp1 = t >> 4, cq1 = t & 15, col1 = C_XS + head * 64 + 4 * cq1;
    u32x4 raw0A[4], raw0B[4]; u32x2 raw1A[2], raw1B[2], zA[2], zB[2]; float dtA = 0.f, dtB = 0.f;
    { SSD_LANE_VARS(tq)
    ssd_load4(ws, b, 0, tg0, col0, raw0A); ssd_load2(ws, b, 0, tp1, col1, raw1A); dtA = ssd_loaddt(ws, b, 0, lane, head);
    ssd_load4(ws, b, 1, tg0, col0, raw0B); ssd_load2(ws, b, 1, tp1, col1, raw1B); dtB = ssd_loaddt(ws, b, 1, lane, head);
#pragma unroll
    for (int i = 0; i < 2; ++i) { const int p0 = ssd_pos(0, 16 * (2 * wl + i) + fr), p1 = ssd_pos(1, 16 * (2 * wl + i) + fr);
        zA[i] = *(const u32x2*)(proj_row(ws, rowof(b, p0 < 0 ? 0 : p0)) + C_Z + head * 64 + 16 * wp + 4 * fq);
        zB[i] = *(const u32x2*)(proj_row(ws, rowof(b, p1 < 0 ? 0 : p1)) + C_Z + head * 64 + 16 * wp + 4 * fq); } }
    f32x4 acc_h[4];
#pragma unroll
    for (int q = 0; q < 4; ++q) acc_h[q] = (f32x4){0.f, 0.f, 0.f, 0.f};
    __syncthreads();
    auto scan = [&](const int c, const float dtv) __attribute__((always_inline)) {
        const int lane = tq & 63;
        const bool ok = ssd_pos(c, lane) >= 0;
        const float dt = ok ? dtv : 0.f; float a = dt * Aneg;
        a += __builtin_bit_cast(float, __builtin_amdgcn_update_dpp(0, __builtin_bit_cast(int, a), 0x111, 0xf, 0xf, false));
        a += __builtin_bit_cast(float, __builtin_amdgcn_update_dpp(0, __builtin_bit_cast(int, a), 0x112, 0xf, 0xf, false));
        a += __builtin_bit_cast(float, __builtin_amdgcn_update_dpp(0, __builtin_bit_cast(int, a), 0x114, 0xf, 0xf, false));
        a += __builtin_bit_cast(float, __builtin_amdgcn_update_dpp(0, __builtin_bit_cast(int, a), 0x118, 0xf, 0xf, false));
        a += __builtin_bit_cast(float, __builtin_amdgcn_update_dpp(0, __builtin_bit_cast(int, a), 0x142, 0xa, 0xf, false));
        a += __builtin_bit_cast(float, __builtin_amdgcn_update_dpp(0, __builtin_bit_cast(int, a), 0x143, 0xc, 0xf, false));
        dt_s2[(c & 1) * 64 + lane] = dt; cs_s2[(c & 1) * 64 + lane] = a;
    };
    if (w == 0) scan(0, dtA);
    __syncthreads();
    auto chunk = [&](const int c, u32x4 (&raw0)[4], u32x2 (&raw1)[2], u32x2 (&zraw)[2], float& dtraw, const float& dt_next) __attribute__((always_inline)) {
        SSD_LANE_VARS(tq)
        LAS float* dt_s = dt_s2 + (c & 1) * 64; LAS float* cs_s = cs_s2 + (c & 1) * 64;
        const int cn = c + 2 < 65 ? c + 2 : 64;
        int yrow[2];
#pragma unroll
        for (int i = 0; i < 2; ++i) { const int pos = ssd_pos(c, 16 * (2 * wl + i) + fr); const bool ok = pos >= 0 && (pos >= NMETA || b == 0); yrow[i] = ok ? rowof(b, pos) : XROWS + 255; }
        const int rowc = b * SEQ + (cn - 1) * 64;
        const bf16_t* pc = (const bf16_t*)(ws + OFF_PROJ) + (size_t)rowc * PROJ_LD;
        dtraw = ((const float*)(ws + OFF_DT))[(size_t)(rowc + lane) * 32 + head];
        {
#pragma unroll
            for (int i = 0; i < 4; ++i) *(LAS u32x4*)((isB ? B_rm : C_rm) + (4 * tg0 + i) * 272 + cg0 * 16) = raw0[i];
            if (isB) {
#pragma unroll
                for (int j = 0; j < 8; ++j) { u32x2 o; o.x = bf_pair(raw0[0][j >> 1], raw0[1][j >> 1], j); o.y = bf_pair(raw0[2][j >> 1], raw0[3][j >> 1], j);
                    *(LAS u32x2*)(BT + (8 * cg0 + j) * 144 + (tg0 ^ (cg0 & 14)) * 8) = o; } }
#pragma unroll
            for (int k = 0; k < 4; ++k) raw0[k] = *(const u32x4*)(pc + (4 * tg0 + k) * PROJ_LD + col0);
        }
        const float cs_last = cs_s[63];
        {
            float xv[2][4];
#pragma unroll
            for (int i = 0; i < 2; ++i) { const u32x2 r = raw1[i];
                xv[i][0] = __uint_as_float(r.x << 16); xv[i][1] = __uint_as_float(r.x & 0xffff0000u); xv[i][2] = __uint_as_float(r.y << 16); xv[i][3] = __uint_as_float(r.y & 0xffff0000u);
                *(LAS u32x2*)(xs_rm + (2 * tp1 + i) * 144 + cq1 * 8) = r; }
            const float d0 = dt_s[2 * tp1], d1 = dt_s[2 * tp1 + 1], w0 = d0 * __expf(cs_last - cs_s[2 * tp1]), w1 = d1 * __expf(cs_last - cs_s[2 * tp1 + 1]);
#pragma unroll
            for (int j = 0; j < 4; ++j) {
                *(LAS unsigned*)(xdtT + (4 * cq1 + j) * 144 + (tp1 ^ (4 * ((cq1 >> 1) & 7))) * 4) = cvt_pk_bf16(xv[0][j] * d0, xv[1][j] * d1);
                *(LAS unsigned*)(xdtwT + (4 * cq1 + j) * 144 + (tp1 ^ (4 * ((cq1 >> 1) & 7))) * 4) = cvt_pk_bf16(xv[0][j] * w0, xv[1][j] * w1); }
#pragma unroll
            for (int k = 0; k < 2; ++k) raw1[k] = *(const u32x2*)(pc + (2 * tp1 + k) * PROJ_LD + col1);
        }
        lds_barrier();
        if (w == 0 && c + 1 < 65) scan(c + 1, dt_next);
        __builtin_amdgcn_sched_barrier(0);
        f32x4 acc_y[2], acc_cb[2];
#pragma unroll
        for (int i = 0; i < 2; ++i) { acc_y[i] = (f32x4){0.f, 0.f, 0.f, 0.f}; acc_cb[i] = (f32x4){0.f, 0.f, 0.f, 0.f}; }
        bf16x8 f_ah[4], f_ab[4], f_cf[4][2];
#pragma unroll
        for (int kb = 0; kb < 4; ++kb) { f_ah[kb] = FRAG(h_bf, 272, 16 * wp + fr, 32 * kb + 8 * fq); f_ab[kb] = FRAG(B_rm, 272, 16 * wp + fr, 32 * kb + 8 * fq);
#pragma unroll
            for (int i = 0; i < 2; ++i) f_cf[kb][i] = FRAG(C_rm, 272, 16 * (2 * wl + i) + fr, 32 * kb + 8 * fq); }
        __builtin_amdgcn_sched_barrier(0);
#pragma unroll
        for (int kb = 0; kb < 4; ++kb)
#pragma unroll
            for (int i = 0; i < 2; ++i) {
                acc_y[i] = __builtin_amdgcn_mfma_f32_16x16x32_bf16(f_ah[kb], f_cf[kb][i], acc_y[i], 0, 0, 0);
                acc_cb[i] = __builtin_amdgcn_mfma_f32_16x16x32_bf16(f_ab[kb], f_cf[kb][i], acc_cb[i], 0, 0, 0); }
        bf16x8 f_xw[2], f_bt[2][4];
#pragma unroll
        for (int kb = 0; kb < 2; ++kb) { f_xw[kb] = *(const LAS bf16x8*)(xdtwT + (16 * wp + fr) * 144 + (((16 * kb + 4 * fq) ^ (4 * ((2 * wp + (fr >> 3)) & 7))) * 4));
#pragma unroll
            for (int q = 0; q < 4; ++q) f_bt[kb][q] = *(const LAS bf16x8*)(BT + (16 * (4 * wl + q) + fr) * 144 + (((8 * kb + 2 * fq) ^ ((8 * wl + 2 * q) & 14)) * 8)); }
        __builtin_amdgcn_sched_barrier(0);
#pragma unroll
        for (int i = 0; i < 2; ++i) { const int l = 16 * (2 * wl + i) + fr; const float csl = cs_s[l], el = __expf(csl);
            const f32x4 css = *(const LAS f32x4*)(cs_s + 16 * wp + 4 * fq);
            float m[4];
#pragma unroll
            for (int r = 0; r < 4; ++r) { acc_y[i][r] *= el; const int sidx = 16 * wp + 4 * fq + r; m[r] = sidx <= l ? acc_cb[i][r] * __expf(csl - css[r]) : 0.f; }
            u32x2 o; o.x = cvt_pk_bf16(m[0], m[1]); o.y = cvt_pk_bf16(m[2], m[3]);
            *(LAS u32x2*)(M_s + l * 144 + (16 * wp + 4 * fq) * 2) = o; }
        __builtin_amdgcn_sched_barrier(0);
        { const float elast = __expf(cs_last);
#pragma unroll
            for (int q = 0; q < 4; ++q) acc_h[q] *= elast;
#pragma unroll
            for (int kb = 0; kb < 2; ++kb)
#pragma unroll
                for (int q = 0; q < 4; ++q) acc_h[q] = __builtin_amdgcn_mfma_f32_16x16x32_bf16(f_bt[kb][q], f_xw[kb], acc_h[q], 0, 0, 0); }
        lds_barrier();
        bf16x8 f_xd[2], f_mf[2][2];
#pragma unroll
        for (int kb = 0; kb < 2; ++kb) { f_xd[kb] = *(const LAS bf16x8*)(xdtT + (16 * wp + fr) * 144 + (((16 * kb + 4 * fq) ^ (4 * ((2 * wp + (fr >> 3)) & 7))) * 4));
#pragma unroll
            for (int i = 0; i < 2; ++i) f_mf[kb][i] = FRAG(M_s, 144, 16 * (2 * wl + i) + fr, 32 * kb + 8 * fq); }
        __builtin_amdgcn_sched_barrier(0);
#pragma unroll
        for (int kb = 0; kb < 2; ++kb)
#pragma unroll
            for (int i = 0; i < 2; ++i) acc_y[i] = __builtin_amdgcn_mfma_f32_16x16x32_bf16(f_xd[kb], f_mf[kb][i], acc_y[i], 0, 0, 0);
#pragma unroll
        for (int q = 0; q < 4; ++q) { u32x2 o; o.x = cvt_pk_bf16(acc_h[q][0], acc_h[q][1]); o.y = cvt_pk_bf16(acc_h[q][2], acc_h[q][3]);
            *(LAS u32x2*)(h_bf + (16 * wp + fr) * 272 + (16 * (4 * wl + q) + 4 * fq) * 2) = o; }
#pragma unroll
        for (int i = 0; i < 2; ++i) { const int l = 16 * (2 * wl + i) + fr;
            const u32x2 xr = *(const LAS u32x2*)(xs_rm + l * 144 + (16 * wp + 4 * fq) * 2);
            const float xv[4] = {__uint_as_float(xr.x << 16), __uint_as_float(xr.x & 0xffff0000u), __uint_as_float(xr.y << 16), __uint_as_float(xr.y & 0xffff0000u)};
            const float zv[4] = {__uint_as_float(zraw[i].x << 16), __uint_as_float(zraw[i].x & 0xffff0000u), __uint_as_float(zraw[i].y << 16), __uint_as_float(zraw[i].y & 0xffff0000u)};
            float o[4], ss = 0.f;
#pragma unroll
            for (int r = 0; r < 4; ++r) { o[r] = (acc_y[i][r] + Dsk * xv[r]) * silu_f(zv[r]); ss += o[r] * o[r]; }
            { u32x2 ov; ov.x = cvt_pk_bf16(o[0], o[1]); ov.y = cvt_pk_bf16(o[2], o[3]); *(u32x2*)((bf16_t*)proj_row(ws, yrow[i]) + C_Z + head * 64 + 16 * wp + 4 * fq) = ov; }
            ss += __shfl_xor(ss, 16); ss += __shfl_xor(ss, 32);
            if (fq == 0) ssq_s[wp * 64 + l] = ss; }
        lds_barrier();
        { const int l = t & 63, pos = ssd_pos(c, l); const bool ok = t < 64 && pos >= 0 && (pos >= NMETA || b == 0);
            ((float*)(ws + OFF_SSQ))[(size_t)(ok ? rowof(b, pos) : XROWS + 255) * 32 + head] = (ssq_s[l] + ssq_s[64 + l]) + (ssq_s[128 + l] + ssq_s[192 + l]); }
#pragma unroll
        for (int i = 0; i < 2; ++i) zraw[i] = *(const u32x2*)(pc + (16 * (2 * wl + i) + fr) * PROJ_LD + C_Z + head * 64 + 16 * wp + 4 * fq);
    };
    for (int c = 0; c < 65; c += 2) {
        chunk(c, raw0A, raw1A, zA, dtA, dtB);
        if (c + 1 < 65) chunk(c + 1, raw0B, raw1B, zB, dtB, dtA);
    }
    __syncthreads();
}

__device__ __forceinline__ void attn_item(const Params& p, LAS unsigned char* lds, int b, int qb, int kv) {
    unsigned char* ws = p.ws;
    const int t = otid(), lane = t & 63, w = __builtin_amdgcn_readfirstlane(t >> 6), fr = lane & 15, fq = lane >> 4, P0 = qb * 128;
    LAS unsigned char* K_s = lds;
    LAS unsigned char* VT_s = lds + 39168;
    __syncthreads();
    for (int task = t; task < 544; task += 512) {
        const int sg = task >> 3, dg = task & 7;
        u32x4 kr[4], vr[4];
#pragma unroll
        for (int i = 0; i < 4; ++i) { const int slot = 4 * sg + i, kpos = slot < 256 ? P0 - 128 + slot : slot - 256;
            if (kpos >= 0 && kpos < NPOS) { const bf16_t* pr = proj_row(ws, rowof(b, kpos)); kr[i] = *(const u32x4*)(pr + C_K + kv * 64 + dg * 8); vr[i] = *(const u32x4*)(pr + C_V + kv * 64 + dg * 8); }
            else { kr[i] = (u32x4){0u, 0u, 0u, 0u}; vr[i] = (u32x4){0u, 0u, 0u, 0u}; } }
#pragma unroll
        for (int i = 0; i < 4; ++i) *(LAS u32x4*)(K_s + (4 * sg + i) * 144 + dg * 16) = kr[i];
#pragma unroll
        for (int j = 0; j < 8; ++j) { u32x2 o; o.x = bf_pair(vr[0][j >> 1], vr[1][j >> 1], j); o.y = bf_pair(vr[2][j >> 1], vr[3][j >> 1], j);
            *(LAS u32x2*)(VT_s + (dg * 8 + j) * 560 + sg * 8) = o; }
    }
    __syncthreads();
    const int g = w & 3, hq = kv * 4 + g;
    const float slope = exp2f(-0.5f * (float)(hq + 1)), sink = p.in[11][hq];
    for (int i4 = 0; i4 < 4; ++i4) {
        const int a = (w >> 2) + 2 * i4, posbase = P0 + 16 * a;
        if (posbase >= NPOS || (posbase < NMETA && b != 0)) continue;
        const int pos = posbase + fr, row = rowof(b, pos), ct0 = a & ~1;
        const bf16_t* qp = proj_row(ws, row) + C_Q + hq * 64 + 8 * fq;
        bf16x8 qf[2]; qf[0] = *(const bf16x8*)qp; qf[1] = *(const bf16x8*)(qp + 32);
        f32x4 S[11];
        bf16x8 kf[11][2];
#pragma unroll
        for (int ct = 0; ct < 11; ++ct) { const int srow = ct < 10 ? 16 * (ct0 + ct) + fr : 256 + fr;
#pragma unroll
            for (int kb = 0; kb < 2; ++kb) kf[ct][kb] = FRAG(K_s, 144, srow, 32 * kb + 8 * fq); }
        __builtin_amdgcn_sched_barrier(0);
#pragma unroll
        for (int ct = 0; ct < 11; ++ct) { S[ct] = (f32x4){0.f, 0.f, 0.f, 0.f};
#pragma unroll
            for (int kb = 0; kb < 2; ++kb) S[ct] = __builtin_amdgcn_mfma_f32_16x16x32_bf16(kf[ct][kb], qf[kb], S[ct], 0, 0, 0); }
        float mx = sink;
        if (qb >= 2) {
            const int D0 = 16 * (a - ct0) + 128 + fr - 4 * fq;
            const float sD0 = -slope * (float)D0;
#pragma unroll
            for (int ct = 0; ct < 11; ++ct)
#pragma unroll
                for (int r = 0; r < 4; ++r) {
                    float sv;
                    if (ct < 10) { sv = S[ct][r] * 0.125f + (sD0 + slope * (float)(16 * ct + r));
                        if (ct < 2 || ct > 7) { const int dist = D0 - 16 * ct - r; sv = (dist >= 0 && dist < 128) ? sv : -1e30f; } }
                    else sv = S[ct][r] * 0.125f;
                    S[ct][r] = sv; mx = fmaxf(mx, sv);
                }
        } else {
#pragma unroll
            for (int ct = 0; ct < 11; ++ct)
#pragma unroll
                for (int r = 0; r < 4; ++r) {
                    float sv; bool ok;
                    if (ct < 10) { const int slot = 16 * (ct0 + ct) + 4 * fq + r, dist = 16 * a + fr + 128 - slot; ok = dist >= 0 && dist < 128 && (P0 - 128 + slot) >= NMETA; sv = S[ct][r] * 0.125f - slope * (float)dist; }
                    else { ok = (4 * fq + r) <= pos; sv = S[ct][r] * 0.125f; }
                    sv = ok ? sv : -1e30f; S[ct][r] = sv; mx = fmaxf(mx, sv);
                }
        }
        mx = fmaxf(mx, __shfl_xor(mx, 16)); mx = fmaxf(mx, __shfl_xor(mx, 32));
        float sum = 0.f;
#pragma unroll
        for (int ct = 0; ct < 11; ++ct)
#pragma unroll
            for (int r = 0; r < 4; ++r) { const float e = __expf(S[ct][r] - mx); S[ct][r] = e; sum += e; }
        sum += __shfl_xor(sum, 16); sum += __shfl_xor(sum, 32);
        sum += __expf(sink - mx);
        f32x4 acc_o[4];
#pragma unroll
        for (int dt = 0; dt < 4; ++dt) acc_o[dt] = (f32x4){0.f, 0.f, 0.f, 0.f};
        u32x4 vw[2][4];
#pragma unroll
        for (int dt = 0; dt < 4; ++dt) { const int sbase = 16 * ct0;
            const u32x2 v0 = *(const LAS u32x2*)(VT_s + (16 * dt + fr) * 560 + (sbase + 4 * fq) * 2), v1 = *(const LAS u32x2*)(VT_s + (16 * dt + fr) * 560 + (sbase + 16 + 4 * fq) * 2);
            vw[0][dt] = (u32x4){v0.x, v0.y, v1.x, v1.y}; }
#pragma unroll
        for (int kb5 = 0; kb5 < 6; ++kb5) {
            if (kb5 + 1 < 6) {
#pragma unroll
                for (int dt = 0; dt < 4; ++dt) { const int sbase = kb5 + 1 < 5 ? 16 * (ct0 + 2 * (kb5 + 1)) : 256;
                    const u32x2 v0 = *(const LAS u32x2*)(VT_s + (16 * dt + fr) * 560 + (sbase + 4 * fq) * 2);
                    u32x2 v1 = (u32x2){0u, 0u};
                    if (kb5 + 1 < 5) v1 = *(const LAS u32x2*)(VT_s + (16 * dt + fr) * 560 + (sbase + 16 + 4 * fq) * 2);
                    vw[(kb5 + 1) & 1][dt] = (u32x4){v0.x, v0.y, v1.x, v1.y}; }
            }
            __builtin_amdgcn_sched_barrier(0);
            u32x4 pw; pw.x = cvt_pk_bf16(S[kb5 < 5 ? 2 * kb5 : 10][0], S[kb5 < 5 ? 2 * kb5 : 10][1]); pw.y = cvt_pk_bf16(S[kb5 < 5 ? 2 * kb5 : 10][2], S[kb5 < 5 ? 2 * kb5 : 10][3]);
            if (kb5 < 5) { pw.z = cvt_pk_bf16(S[kb5 < 5 ? 2 * kb5 + 1 : 10][0], S[kb5 < 5 ? 2 * kb5 + 1 : 10][1]); pw.w = cvt_pk_bf16(S[kb5 < 5 ? 2 * kb5 + 1 : 10][2], S[kb5 < 5 ? 2 * kb5 + 1 : 10][3]); }
            else { pw.z = 0u; pw.w = 0u; }
#pragma unroll
            for (int dt = 0; dt < 4; ++dt)
                acc_o[dt] = __builtin_amdgcn_mfma_f32_16x16x32_bf16(__builtin_bit_cast(bf16x8, vw[kb5 & 1][dt]), __builtin_bit_cast(bf16x8, pw), acc_o[dt], 0, 0, 0);
        }
        const float inv = 1.f / sum;
        bf16_t* op = (bf16_t*)proj_row(ws, row) + C_Q + hq * 64 + 4 * fq;
#pragma unroll
        for (int dt = 0; dt < 4; ++dt) { u32x2 o; o.x = cvt_pk_bf16(acc_o[dt][0] * inv, acc_o[dt][1] * inv); o.y = cvt_pk_bf16(acc_o[dt][2] * inv, acc_o[dt][3] * inv); *(u32x2*)(op + 16 * dt) = o; }
    }
    __syncthreads();
}

__device__ __forceinline__ void phase_mixer(const Params& p, LAS unsigned char* lds) {
    const int c = obid(), G = gridDim.x;
    for (int it = c; it < 256; it += G) ssd_item(p, lds, it >> 5, it & 31);
    for (int it = c; it < 8 * 33 * 4; it += G) {
        int kv, qb, b;
        if (it < 1024) { kv = it & 3; qb = (it >> 2) & 31; b = it >> 7; } else { const int j = it - 1024; kv = j & 3; qb = 32; b = j >> 2; }
        attn_item(p, lds, b, qb, kv); }
}

__device__ __forceinline__ void phase_e1(const Params& p) {
    const int tid_ = otid(), lane = tid_ & 63, gw = obid() * 8 + (tid_ >> 6), NGW = gridDim.x * 8;
    f32x4 w1v[4], w2v[4];
#pragma unroll
    for (int j = 0; j < 4; ++j) { w1v[j] = *(const f32x4*)(p.in[14] + (lane + 64 * j) * 4); w2v[j] = *(const f32x4*)(p.in[15] + (lane + 64 * j) * 4); }
    for (int r0 = gw; r0 < MROWS; r0 += 4 * NGW) {
        f32x4 v[4][4], hv[4][4];
#pragma unroll
        for (int i = 0; i < 4; ++i) { const int r = r0 + i * NGW; const bool real = r < XROWS + NMETA; const int rc = real ? r : 0;
            const bf16_t* mx = (const bf16_t*)(p.ws + OFF_MIX) + (size_t)rc * D;
            const float* hs = rc < XROWS ? p.in[0] + (size_t)rc * D : p.in[1] + (size_t)(rc - XROWS) * D;
#pragma unroll
            for (int j = 0; j < 4; ++j) { const u32x2 m2 = __builtin_nontemporal_load((const u32x2*)(mx + (lane + 64 * j) * 4));
                v[i][j] = (f32x4){__uint_as_float(m2.x << 16), __uint_as_float(m2.x & 0xffff0000u), __uint_as_float(m2.y << 16), __uint_as_float(m2.y & 0xffff0000u)};
                hv[i][j] = __builtin_nontemporal_load((const f32x4*)(hs + (lane + 64 * j) * 4)); } }
#pragma unroll
        for (int i = 0; i < 4; ++i) { const int r = r0 + i * NGW;
            if (r >= MROWS) continue;
            const bool real = r < XROWS + NMETA;
            bf16_t* dst = (bf16_t*)(p.ws + OFF_HN2) + (size_t)r * D;
            float s = 0.f;
#pragma unroll
            for (int j = 0; j < 4; ++j) s += (v[i][j][0] * v[i][j][0] + v[i][j][1] * v[i][j][1]) + (v[i][j][2] * v[i][j][2] + v[i][j][3] * v[i][j][3]);
            const float rs1 = rsqrtf(wave_sum(s) * (1.f / D) + EPS);
            float s2 = 0.f;
#pragma unroll
            for (int j = 0; j < 4; ++j)
#pragma unroll
                for (int q = 0; q < 4; ++q) { v[i][j][q] = hv[i][j][q] + v[i][j][q] * rs1 * w1v[j][q]; s2 += v[i][j][q] * v[i][j][q]; }
            const float rs2 = real ? rsqrtf(wave_sum(s2) * (1.f / D) + EPS) : 0.f;
#pragma unroll
            for (int j = 0; j < 4; ++j) {
                u32x2 o; o.x = cvt_pk_bf16(v[i][j][0] * rs2 * w2v[j][0], v[i][j][1] * rs2 * w2v[j][1]); o.y = cvt_pk_bf16(v[i][j][2] * rs2 * w2v[j][2], v[i][j][3] * rs2 * w2v[j][3]);
                *(u32x2*)(dst + (lane + 64 * j) * 4) = o; }
        }
    }
}
__device__ __forceinline__ void phase_e3(const Params& p) {
    const int tid_ = otid(), lane = tid_ & 63, gw = obid() * 8 + (tid_ >> 6), NGW = gridDim.x * 8;
    f32x4 w3v[4], w1v[4];
#pragma unroll
    for (int j = 0; j < 4; ++j) { w3v[j] = *(const f32x4*)(p.in[20] + (lane + 64 * j) * 4); w1v[j] = *(const f32x4*)(p.in[14] + (lane + 64 * j) * 4); }
    for (int r0 = gw; r0 < XROWS; r0 += 4 * NGW) {
        f32x4 hv[4][4]; u32x2 fr2[4][4], mr2[4][4];
#pragma unroll
        for (int i = 0; i < 4; ++i) { const int r = r0 + i * NGW; const int rc = r < XROWS ? r : 0;
#pragma unroll
            for (int j = 0; j < 4; ++j) { fr2[i][j] = __builtin_nontemporal_load((const u32x2*)((const bf16_t*)(p.ws + OFF_FFN) + (size_t)rc * D + (lane + 64 * j) * 4));
                mr2[i][j] = __builtin_nontemporal_load((const u32x2*)((const bf16_t*)(p.ws + OFF_MIX) + (size_t)rc * D + (lane + 64 * j) * 4));
                hv[i][j] = __builtin_nontemporal_load((const f32x4*)(p.in[0] + (size_t)rc * D + (lane + 64 * j) * 4)); } }
#pragma unroll
        for (int i = 0; i < 4; ++i) { const int r = r0 + i * NGW;
            if (r >= XROWS) continue;
            f32x4 v[4], mv[4];
            float s = 0.f, sm = 0.f;
#pragma unroll
            for (int j = 0; j < 4; ++j) {
                v[j] = (f32x4){__uint_as_float(fr2[i][j].x << 16), __uint_as_float(fr2[i][j].x & 0xffff0000u), __uint_as_float(fr2[i][j].y << 16), __uint_as_float(fr2[i][j].y & 0xffff0000u)};
                mv[j] = (f32x4){__uint_as_float(mr2[i][j].x << 16), __uint_as_float(mr2[i][j].x & 0xffff0000u), __uint_as_float(mr2[i][j].y << 16), __uint_as_float(mr2[i][j].y & 0xffff0000u)};
                s += (v[j][0] * v[j][0] + v[j][1] * v[j][1]) + (v[j][2] * v[j][2] + v[j][3] * v[j][3]);
                sm += (mv[j][0] * mv[j][0] + mv[j][1] * mv[j][1]) + (mv[j][2] * mv[j][2] + mv[j][3] * mv[j][3]); }
            const float rs = rsqrtf(wave_sum(s) * (1.f / D) + EPS), rs1 = rsqrtf(wave_sum(sm) * (1.f / D) + EPS);
#pragma unroll
            for (int j = 0; j < 4; ++j) { f32x4 o;
#pragma unroll
                for (int q = 0; q < 4; ++q) o[q] = (hv[i][j][q] + mv[j][q] * rs1 * w1v[j][q]) + v[j][q] * rs * w3v[j][q];
                __builtin_nontemporal_store(o, (f32x4*)(p.out + (size_t)r * D + (lane + 64 * j) * 4)); }
        }
    }
}
__device__ __forceinline__ void phase_e2(const Params& p) {
    const int t = otid(), tc = t & 7, tr = t >> 3, lr0 = tr * 4;
    bf16_t* U = (bf16_t*)(p.ws + OFF_U); const bf16_t* halo = (const bf16_t*)(p.ws + OFF_HALO);
    const float* cw = p.in[17]; const float* cb = p.in[18];
    const int G = gridDim.x, NIT = 128 * 44;
    for (int it0 = obid(); it0 < NIT; it0 += 2 * G) {
        u32x4 ra[2][6], rg[2][6];
#pragma unroll
        for (int q = 0; q < 2; ++q) { const int it = it0 + q * G < NIT ? it0 + q * G : it0; const int pm = it / 44, c = (it % 44) * 64 + tc * 8;
#pragma unroll
            for (int k = 0; k < 6; ++k) { const int lr = lr0 - 2 + k;
                const bf16_t* src = lr >= 0 ? U + (size_t)(pm * 256 + lr) * U_LD : halo + (size_t)(((pm & 15) == 0 ? META_TILE : pm - 1) * 2 + (lr + 2)) * U_LD;
                ra[q][k] = *(const u32x4*)(src + c); rg[q][k] = *(const u32x4*)(src + FF + c); } }
        __syncthreads();
#pragma unroll
        for (int q = 0; q < 2; ++q) { const int it = it0 + q * G < NIT ? it0 + q * G : it0; const int pm = it / 44, c = (it % 44) * 64 + tc * 8; u32x4 o[4];
            float wa[3][8], wg[3][8], ba[8], bg[8];
#pragma unroll
            for (int j = 0; j < 8; ++j) { ba[j] = cb[c + j]; bg[j] = cb[FF + c + j];
#pragma unroll
                for (int k = 0; k < 3; ++k) { wa[k][j] = cw[k * 5632 + c + j]; wg[k][j] = cw[k * 5632 + FF + c + j]; } }
#pragma unroll
            for (int i = 0; i < 4; ++i) { float av[8], gv[8];
#pragma unroll
                for (int j = 0; j < 8; ++j) { av[j] = ba[j]; gv[j] = bg[j]; }
#pragma unroll
                for (int k = 0; k < 3; ++k) { float ua[8], ug[8]; unpack8(ra[q][i + k], ua); unpack8(rg[q][i + k], ug);
#pragma unroll
                    for (int j = 0; j < 8; ++j) { av[j] += wa[k][j] * ua[j]; gv[j] += wg[k][j] * ug[j]; } }
                float r[8];
#pragma unroll
                for (int j = 0; j < 8; ++j) r[j] = silu_f(av[j]) * gv[j];
                o[i] = pack8(r); }
            if (it0 + q * G < NIT) {
#pragma unroll
                for (int i = 0; i < 4; ++i) *(u32x4*)(U + (size_t)(pm * 256 + lr0 + i) * U_LD + c) = o[i]; } }
    }
}

__device__ __forceinline__ void phase_conv(const Params& p) {
    const int t = otid(), tc = t & 7, tr = t >> 3, lr0 = tr * 4;
    unsigned char* ws = p.ws;
    const bf16_t* halo = (const bf16_t*)(ws + OFF_HALO1);
    const float* cw = p.in[4]; const float* cb = p.in[5];
    const int G = gridDim.x, NIT = 129 * 48;
    for (int it0 = obid(); it0 < NIT; it0 += 2 * G) {
        u32x4 raw[2][7];
#pragma unroll
        for (int q = 0; q < 2; ++q) { const int it = it0 + q * G < NIT ? it0 + q * G : it0; const int pml = it / 48, c = (it % 48) * 64 + tc * 8;
            const bool meta = pml == META_TILE; const int pm = pml;
            const bf16_t* base = (const bf16_t*)(ws + OFF_PROJ) + (size_t)(pml * 256) * PROJ_LD;
#pragma unroll
            for (int k = 0; k < 7; ++k) { const int lr = lr0 - 3 + k;
                if (lr >= 0) raw[q][k] = *(const u32x4*)(base + (size_t)lr * PROJ_LD + C_XS + c);
                else if (meta) raw[q][k] = (u32x4){0u, 0u, 0u, 0u};
                else raw[q][k] = *(const u32x4*)(halo + (size_t)(((pm & 15) == 0 ? META_TILE : pm - 1) * 3 + (lr + 3)) * 3072 + c); } }
        __syncthreads();
#pragma unroll
        for (int q = 0; q < 2; ++q) { const int it = it0 + q * G < NIT ? it0 + q * G : it0; const int pml = it / 48, c = (it % 48) * 64 + tc * 8;
            bf16_t* base = (bf16_t*)(ws + OFF_PROJ) + (size_t)(pml * 256) * PROJ_LD;
            float wv[5][8];
#pragma unroll
            for (int j = 0; j < 8; ++j) { wv[4][j] = cb[c + j];
#pragma unroll
                for (int k = 0; k < 4; ++k) wv[k][j] = cw[k * 3072 + c + j]; }
#pragma unroll
            for (int i = 0; i < 4; ++i) { float a[8];
#pragma unroll
                for (int j = 0; j < 8; ++j) a[j] = wv[4][j];
#pragma unroll
                for (int k = 0; k < 4; ++k) { float u[8]; unpack8(raw[q][i + k], u);
#pragma unroll
                    for (int j = 0; j < 8; ++j) a[j] += wv[k][j] * u[j]; }
#pragma unroll
                for (int j = 0; j < 8; ++j) a[j] = silu_f(a[j]);
                if (it0 + q * G < NIT) *(u32x4*)(base + (size_t)(lr0 + i) * PROJ_LD + C_XS + c) = pack8(a); } }
    }
}

__device__ __forceinline__ f32x4 skinny_dot(const bf16_t* A, int lda, const bf16_t* Bt, int ldb, int j, int K, int fr, int fq, f32x4 acc) {
    const bf16_t* ap = A + (size_t)fr * lda + 8 * fq; const bf16_t* bp = Bt + (size_t)(16 * j + fr) * ldb + 8 * fq;
#pragma unroll 8
    for (int k0 = 0; k0 < K; k0 += 32) acc = __builtin_amdgcn_mfma_f32_16x16x32_bf16(*(const bf16x8*)(bp + k0), *(const bf16x8*)(ap + k0), acc, 0, 0, 0);
    return acc;
}
__device__ __forceinline__ f32x4 skinny_splitk(const bf16_t* A, int lda, const bf16_t* Bt, int ldb, int j, int K, LAS float* red, int t) {
    const int lane = t & 63, w = t >> 6, fr = lane & 15, fq = lane >> 4, ks = K >> 3;
    const f32x4 part = skinny_dot(A + w * ks, lda, Bt + w * ks, ldb, j, ks, fr, fq, (f32x4){0.f, 0.f, 0.f, 0.f});
    __syncthreads();
    *(LAS f32x4*)(red + (w * 64 + lane) * 4) = part;
    __syncthreads();
    f32x4 sum = {0.f, 0.f, 0.f, 0.f};
    if (w == 0) {
#pragma unroll
        for (int i = 0; i < 8; ++i) sum += *(const LAS f32x4*)(red + (i * 64 + lane) * 4); }
    return sum;
}
__device__ __forceinline__ void meta_g2(const Params& p, LAS unsigned char* lds) {
    unsigned char* ws = p.ws;
    const int t = otid(), lane = t & 63, fr = lane & 15, fq = lane >> 4;
    for (int j = obid(); j < 64; j += gridDim.x) {
        const bf16_t* A = (const bf16_t*)(ws + OFF_PROJ) + (size_t)XROWS * PROJ_LD; const bf16_t* W = (const bf16_t*)(ws + OFF_WG2);
        const f32x4 a1 = skinny_splitk(A + C_Z, PROJ_LD, W, A2_LD, j, 2048, (LAS float*)lds, t), a2 = skinny_splitk(A + C_Q, PROJ_LD, W + 2048, A2_LD, j, 1024, (LAS float*)lds, t);
        if (t >= 64) continue;
        const f32x4* sq = (const f32x4*)((const float*)(ws + OFF_SSQ) + (size_t)(XROWS + fr) * 32);
        float ssum = 0.f;
#pragma unroll
        for (int i = 0; i < 8; ++i) { const f32x4 v = sq[i]; ssum += (v[0] + v[1]) + (v[2] + v[3]); }
        const float rs = rsqrtf(ssum * (1.f / 2048.f) + EPS);
        const bf16_t* pr = (const bf16_t*)(ws + OFF_PROJ) + (size_t)(XROWS + fr) * PROJ_LD + 16 * j + 4 * fq;
        const u32x2 gsr = *(const u32x2*)(pr + C_GS), gar = *(const u32x2*)(pr + C_GA);
        const float gs[4] = {__uint_as_float(gsr.x << 16), __uint_as_float(gsr.x & 0xffff0000u), __uint_as_float(gsr.y << 16), __uint_as_float(gsr.y & 0xffff0000u)};
        const float ga[4] = {__uint_as_float(gar.x << 16), __uint_as_float(gar.x & 0xffff0000u), __uint_as_float(gar.y << 16), __uint_as_float(gar.y & 0xffff0000u)};
        float o[4];
#pragma unroll
        for (int r = 0; r < 4; ++r) o[r] = sigmoid_f(gs[r]) * rs * a1[r] + sigmoid_f(ga[r]) * a2[r];
        u32x2 ov; ov.x = cvt_pk_bf16(o[0], o[1]); ov.y = cvt_pk_bf16(o[2], o[3]);
        *(u32x2*)((bf16_t*)(ws + OFF_MBUF_META) + (size_t)fr * D + 16 * j + 4 * fq) = ov;
    }
}
__device__ __forceinline__ void meta_gates(const Params& p, LAS unsigned char* lds) {
    unsigned char* ws = p.ws;
    const int t = otid(), lane = t & 63, fr = lane & 15, fq = lane >> 4;
    for (int j = obid(); j < 128; j += gridDim.x) {
        const f32x4 a = skinny_splitk((const bf16_t*)(ws + OFF_HN_META), D, (const bf16_t*)(ws + OFF_WIN) + (size_t)(26 * 256) * D, D, j, 1024, (LAS float*)lds, t);
        if (t >= 64) continue;
        u32x2 ov; ov.x = cvt_pk_bf16(a[0], a[1]); ov.y = cvt_pk_bf16(a[2], a[3]);
        *(u32x2*)((bf16_t*)(ws + OFF_PROJ) + (size_t)(XROWS + fr) * PROJ_LD + C_GS + 16 * j + 4 * fq) = ov;
    }
}
__device__ __forceinline__ void meta_g3(const Params& p, LAS unsigned char* lds) {
    unsigned char* ws = p.ws;
    const int t = otid(), lane = t & 63, fr = lane & 15, fq = lane >> 4;
    for (int j = obid(); j < 64; j += gridDim.x) {
        const f32x4 a = skinny_splitk((const bf16_t*)(ws + OFF_MBUF_META), D, (const bf16_t*)(ws + OFF_WMIX), D, j, 1024, (LAS float*)lds, t);
        if (t >= 64) continue;
        u32x2 ov; ov.x = cvt_pk_bf16(a[0], a[1]); ov.y = cvt_pk_bf16(a[2], a[3]);
        *(u32x2*)((bf16_t*)(ws + OFF_MIX) + (size_t)(XROWS + fr) * D + 16 * j + 4 * fq) = ov;
    }
}
__device__ __forceinline__ void meta_g4(const Params& p, LAS unsigned char* lds) {
    unsigned char* ws = p.ws;
    const int t = otid(), lane = t & 63, fr = lane & 15, fq = lane >> 4;
    for (int j = obid(); j < 352; j += gridDim.x) {
        const f32x4 a = skinny_splitk((const bf16_t*)(ws + OFF_HN2) + (size_t)XROWS * D, D, (const bf16_t*)(ws + OFF_WUP), D, j, 1024, (LAS float*)lds, t);
        if (t >= 64) continue;
        u32x2 ov; ov.x = cvt_pk_bf16(a[0], a[1]); ov.y = cvt_pk_bf16(a[2], a[3]);
        const int np = 16 * j + 4 * fq, col = ((np & 128) ? FF : 0) + 128 * (np >> 8) + (np & 127);
        if (fr >= 14) *(u32x2*)((bf16_t*)(ws + OFF_RAWM) + (size_t)(fr - 14) * U_LD + col) = ov;
    }
}

#define XB_TMO      128
#define XB_XCNT(j)  (256  + 64 * (j))
#define XB_XSUB(j)  (1280 + 64 * (j))
#define XB_XGEN(j)  (2304 + 64 * (j))
#define XB_TOP      3328
#define XB_TOPGEN   3392
#define XCD_BAR_WORDS 3456
#define XB_SPIN_CAP (1u << 18)

__device__ __forceinline__ unsigned xb_ld(unsigned* p)              { return __hip_atomic_load(p, __ATOMIC_RELAXED, __HIP_MEMORY_SCOPE_AGENT); }
__device__ __forceinline__ unsigned xb_add(unsigned* p, unsigned v) { return __hip_atomic_fetch_add(p, v, __ATOMIC_RELAXED, __HIP_MEMORY_SCOPE_AGENT); }
__device__ __forceinline__ unsigned xb_xcc_id() { return (unsigned)__builtin_amdgcn_s_getreg((3 << 11) | 20) & 0xFu; }
#define XB_SPIN(cond, bar) do { unsigned _sp = 0; while (cond) { __builtin_amdgcn_s_sleep(1); \
    if ((++_sp & 255u) == 0u) { if (xb_ld(&(bar)[XB_TMO])) break; if (_sp > XB_SPIN_CAP) { atomicAdd(&(bar)[XB_TMO], 1u); break; } } } } while (0)

struct XcdBarrier {
    unsigned* bar; unsigned x;
    volatile LAS unsigned* st;
};

__device__ __forceinline__ XcdBarrier xcd_barrier_post(unsigned* bar, volatile LAS unsigned* st) {
    XcdBarrier b; b.bar = bar; b.x = xb_xcc_id(); b.st = st;
    if (threadIdx.x == 0) (void)xb_add(&bar[XB_XCNT(b.x)], 1u);
    return b;
}
__device__ __forceinline__ void xcd_barrier_complete(unsigned* bar, unsigned x, unsigned& nloc, unsigned& nx) {
    const unsigned G = gridDim.x * gridDim.y * gridDim.z;
    unsigned sum, cnt, mine, sp = 0u;
    for (;;) {
        sum = 0u; cnt = 0u; mine = 0u;
#pragma unroll
        for (unsigned j = 0; j < 16; ++j) { const unsigned c = xb_ld(&bar[XB_XCNT(j)]); sum += c; cnt += (c > 0u) ? 1u : 0u; mine = (j == x) ? c : mine; }
        if (sum == G) break;
        __builtin_amdgcn_s_sleep(1);
        if ((++sp & 255u) == 0u) { if (xb_ld(&bar[XB_TMO])) break; if (sp > XB_SPIN_CAP) { atomicAdd(&bar[XB_TMO], 1u); break; } }
    }
    nloc = mine > 0u ? mine : 1u; nx = cnt > 0u ? cnt : 1u;
}

__device__ __forceinline__ void xcd_barrier(const XcdBarrier& b) {
    asm volatile("s_waitcnt vmcnt(0)" ::: "memory");
    __syncthreads();
    if (threadIdx.x == 0) {
        unsigned* bar = b.bar;
        __builtin_amdgcn_s_waitcnt(0);
        unsigned nloc = b.st[0], nx = b.st[1];
        if (nloc == 0u) { xcd_barrier_complete(bar, b.x, nloc, nx); b.st[0] = nloc; b.st[1] = nx; }
        const unsigned old = xb_add(&bar[XB_XSUB(b.x)], 1u);
        const unsigned gen = old / nloc;
        if (old + 1u == (gen + 1u) * nloc) {
            __builtin_amdgcn_fence(__ATOMIC_RELEASE, "agent");
            asm volatile("s_waitcnt vmcnt(0)" ::: "memory");
            const unsigned og = xb_add(&bar[XB_TOP], 1u);
            const unsigned tg = og / nx;
            if (og + 1u == (tg + 1u) * nx) xb_add(&bar[XB_TOPGEN], 1u);
            else XB_SPIN(xb_ld(&bar[XB_TOPGEN]) == tg, bar);
            __builtin_amdgcn_fence(__ATOMIC_ACQUIRE, "agent");
            xb_add(&bar[XB_XGEN(b.x)], 1u);
            asm volatile("s_waitcnt vmcnt(0)" ::: "memory");
        } else {
            XB_SPIN(xb_ld(&bar[XB_XGEN(b.x)]) == gen, bar);
            __builtin_amdgcn_fence(__ATOMIC_ACQUIRE, "agent");
            asm volatile("s_waitcnt vmcnt(0)" ::: "memory");
        }
    }
    __syncthreads();
}


__device__ __forceinline__ void sched_init(pg8::Sched& S, int nM, int nN, int parts, int mt0, int has_meta, int nt0, int nt1, const void* Ax, const void* Am, const void* B, size_t a_tile, size_t b_tile) {
    S.nM = nM; S.nN = nN; S.nwg = nM * nN; S.G = gridDim.x; S.c = obid(); S.parts = parts; S.mt0 = mt0; S.has_meta = has_meta; S.nt0 = nt0; S.nt1 = nt1;
    S.Ax = (const char*)Ax; S.Am = (const char*)Am; S.B = (const char*)B; S.a_tile = a_tile; S.b_tile = b_tile; S.pn_base = 0; S.pn_last = -1; S.a_part1 = (size_t)nt0 * 128;
}
__device__ __forceinline__ void run_phase(const Params& p, LAS unsigned char* lds, int ph) {
    unsigned char* ws = p.ws;
    pg8::Sched S;
    switch (ph) {
#ifndef PHM
#define PHM 0x7fff
#endif
#define PH_ON(x) ((PHM >> (x)) & 1)
    case 0: if (PH_ON(0)) phase_prep(p, lds); break;
    case 1: if (PH_ON(1)) {
        sched_init(S, 129, 27, 1, 0, 1, 16, 0, p.out, ws + OFF_HN_META, ws + OFF_WIN, (size_t)256 * D * 2, (size_t)256 * D * 2); S.pn_last = 34;
        EpiG1 E{ws, p.in[6], p.in[4], p.in[5]}; pg8::gemm_phase(lds, D, D, S, E); } break;
    case 2: if (PH_ON(2)) phase_mixer(p, lds); break;
    case 3: if (PH_ON(3)) {
        meta_gates(p, lds); __syncthreads();
        sched_init(S, 128, 8, 1, 0, 0, 16, 0, p.out, ws + OFF_HN_META, ws + OFF_WIN, (size_t)256 * D * 2, (size_t)256 * D * 2); S.pn_base = 26;
        EpiG1 E{ws, p.in[6], p.in[4], p.in[5]}; pg8::gemm_phase(lds, D, D, S, E); } break;
    case 4: if (PH_ON(4)) {
        meta_g2(p, lds); __syncthreads();
        sched_init(S, 128, 4, 2, 0, 0, 32, 16, ws + OFF_PROJ + (size_t)C_Z * 2, ws + OFF_PROJ, ws + OFF_WG2, (size_t)256 * PROJ_LD * 2, (size_t)256 * A2_LD * 2); S.a_part1 = (size_t)(C_Q - C_Z) * 2;
        EpiG2 E{ws, (bf16_t*)((unsigned char*)p.out + 64 * MiB)}; pg8::gemm_phase(lds, PROJ_LD, A2_LD, S, E); } break;
    case 5: if (PH_ON(5)) { meta_g3(p, lds); __syncthreads();
        sched_init(S, 128, 4, 1, 0, 0, 16, 0, (unsigned char*)p.out + 64 * MiB, ws + OFF_MBUF_META, ws + OFF_WMIX, (size_t)256 * D * 2, (size_t)256 * D * 2);
        EpiB16 E{(bf16_t*)(ws + OFF_MIX)}; pg8::gemm_phase(lds, D, D, S, E); } break;
    case 6: if (PH_ON(6)) phase_e1(p); break;
    case 7: if (PH_ON(7)) { meta_g4(p, lds); __syncthreads();
        sched_init(S, 128, 22, 1, 0, 0, 16, 0, ws + OFF_HN2, ws + OFF_HN2 + (size_t)128 * 256 * D * 2, ws + OFF_WUP, (size_t)256 * D * 2, (size_t)256 * D * 2);
        EpiG4F E{(bf16_t*)(ws + OFF_U), (bf16_t*)(ws + OFF_RAW), p.in[17], p.in[18]}; pg8::gemm_phase(lds, D, D, S, E); } break;
    case 8: if (PH_ON(8)) { sched_init(S, 128, 4, 1, 0, 0, 44, 0, ws + OFF_U, ws + OFF_U, ws + OFF_WDN, (size_t)256 * FF * 2, (size_t)256 * FF * 2);
        { pg8::Unit uu; int last = -1; for (int j = 0; S.next(j, uu); ++j) if (uu.pm != last) { ffn_fixup(p, uu.pm); last = uu.pm; } }
        asm volatile("s_waitcnt vmcnt(0)" ::: "memory"); __syncthreads();
        EpiB16 E{(bf16_t*)(ws + OFF_FFN)}; pg8::gemm_phase(lds, FF, FF, S, E); } break;
    case 9: if (PH_ON(9)) phase_e3(p); break;
    }
}

__global__ __launch_bounds__(512, 2) void fwd_kernel(Params p) {
    extern __shared__ __attribute__((aligned(16))) unsigned char shm[];
    LAS unsigned char* lds = (LAS unsigned char*)shm;
#ifndef REPEAT_MASK
#define REPEAT_MASK 0
#endif
    volatile LAS unsigned* st = (volatile LAS unsigned*)(lds + 131072);
    if (threadIdx.x == 0) { st[0] = 0u; st[1] = 0u; }
    __syncthreads();
    const XcdBarrier xb = xcd_barrier_post((unsigned*)(p.ws + OFF_BAR), st);
    for (int ph = p.ph_lo; ph < p.ph_hi; ++ph) {
        run_phase(p, lds, ph);
        if (REPEAT_MASK && ((REPEAT_MASK >> ph) & 1)) { cg::this_grid().sync(); run_phase(p, lds, ph); }
        if (ph + 1 < p.ph_hi) { if (p.ph_hi > NPHASE) cg::this_grid().sync(); else xcd_barrier(xb); }
    }
}

extern "C" void kernel_launch(void* const* d_in, const int* in_sizes, int n_in, void* d_out, int out_size, void* d_ws, size_t ws_size, hipStream_t stream) {
    static int grid = 0;
    if (grid == 0) {
        if (n_in != 21 || ws_size < WS_NEED) { fprintf(stderr, "kernel_launch: unexpected n_in %d / ws_size %zu\n", n_in, ws_size); grid = -1; return; }
        int dev = 0, cus = 0, per_cu = 0;
        hipGetDevice(&dev); hipDeviceGetAttribute(&cus, hipDeviceAttributeMultiprocessorCount, dev);
        hipFuncSetAttribute((const void*)fwd_kernel, hipFuncAttributeMaxDynamicSharedMemorySize, LDS_BYTES);
        hipOccupancyMaxActiveBlocksPerMultiprocessor(&per_cu, (const void*)fwd_kernel, 512, LDS_BYTES);
        if (per_cu < 1) { fprintf(stderr, "kernel_launch: occupancy query says %d\n", per_cu); per_cu = 1; }
        grid = cus;
    }
    if (grid < 0) return;
    Params p{};
    for (int i = 0; i < 21; ++i) p.in[i] = (const float*)d_in[i];
    p.out = (float*)d_out; p.ws = (unsigned char*)d_ws;
#if ONE_LAUNCH
    if (hipMemsetAsync((unsigned char*)d_ws + OFF_BAR, 0, XCD_BAR_WORDS * sizeof(unsigned), stream) != hipSuccess) { fprintf(stderr, "kernel_launch: memset of barrier words failed\n"); return; }
    p.ph_lo = 0; p.ph_hi = NPHASE;
    void* args[] = {&p};
    hipError_t e = hipLaunchCooperativeKernel((const void*)fwd_kernel, dim3(grid), dim3(512), args, LDS_BYTES, stream);
    if (e != hipSuccess) fprintf(stderr, "cooperative launch failed: %s (grid %d)\n", hipGetErrorString(e), grid);
#else
    for (int ph = 0; ph < NPHASE; ++ph) {
        p.ph_lo = ph; p.ph_hi = ph + 1;
        hipLaunchKernelGGL(fwd_kernel, dim3(grid), dim3(512), LDS_BYTES, stream, p);
    }
#endif
}
```

```cpp
#include <hip/hip_runtime.h>
#include <hip/hip_cooperative_groups.h>
#include <cstdio>
namespace cg = cooperative_groups;

#define LAS __attribute__((address_space(3)))
typedef unsigned short bf16_t;
typedef short bf16x8 __attribute__((ext_vector_type(8)));
typedef float f32x4 __attribute__((ext_vector_type(4)));
typedef unsigned u32x4 __attribute__((ext_vector_type(4)));
typedef unsigned u32x2 __attribute__((ext_vector_type(2)));

#ifndef ONE_LAUNCH
#define ONE_LAUNCH 1
#endif

constexpr int D = 1024, SEQ = 4096, NMETA = 16, NPOS = SEQ + NMETA;
constexpr int XROWS = 32768, MROWS = 33024, META_TILE = 128;
constexpr int PROJ_LD = 6656, NIN_PAD = 8960;
constexpr int C_Z = 0, C_XS = 2048, C_Q = 5120, C_K = 6144, C_V = 6400, C_GS = 2048, C_GA = 3072;
constexpr int A2_LD = 3072, FF = 2816, U_LD = 5632;
constexpr float EPS = 1e-6f;
constexpr size_t MiB = 1048576;
constexpr size_t OFF_WDN = 0, OFF_WUP = 6 * MiB, OFF_WMIX = 17 * MiB, OFF_WG2 = 19 * MiB, OFF_WIN = 25 * MiB, OFF_DT = 43 * MiB, OFF_SSQ = 48 * MiB,
                 OFF_HN_META = 60 * MiB, OFF_MBUF_META = 61 * MiB, OFF_PROJ = 64 * MiB,
                 OFF_MIX = 240 * MiB, OFF_U = 17 * MiB, OFF_HN2 = 372 * MiB, OFF_FFN = 372 * MiB, OFF_HALO = 502 * MiB, OFF_HALO1 = 505 * MiB, OFF_BAR = 508 * MiB, WS_NEED = 509 * MiB,
                 OFF_RAW = 200 * MiB, OFF_RAWM = 230 * MiB,
                 OFF_RAW1 = 483 * MiB + MiB / 2, OFF_RAW1M = 505 * MiB;
constexpr int LDS_BYTES = 131072 + 16;
constexpr int NPHASE = 10;

struct Params {
    const float* in[21];
    float* out;
    unsigned char* ws;
    int ph_lo, ph_hi;
};

__device__ __forceinline__ int otid() { int t = threadIdx.x; asm volatile("" : "+v"(t)); return t; }
__device__ __forceinline__ int obid() { int t = blockIdx.x; asm volatile("" : "+s"(t)); return t; }
__device__ __forceinline__ void lds_barrier() { asm volatile("s_waitcnt lgkmcnt(0)\n\ts_barrier" ::: "memory"); }
__device__ __forceinline__ float bf2f(unsigned b) { return __uint_as_float(b << 16); }
typedef float f32x2_t __attribute__((ext_vector_type(2)));
typedef __bf16 bf16x2_t __attribute__((ext_vector_type(2)));
__device__ __forceinline__ unsigned cvt_pk_bf16(float lo, float hi) { const f32x2_t v = {lo, hi}; return __builtin_bit_cast(unsigned, __builtin_convertvector(v, bf16x2_t)); }
__device__ __forceinline__ void unpack8(const u32x4 v, float* f) {
#pragma unroll
    for (int i = 0; i < 4; ++i) { f[2 * i] = __uint_as_float(v[i] << 16); f[2 * i + 1] = __uint_as_float(v[i] & 0xffff0000u); }
}
__device__ __forceinline__ u32x4 pack8(const float* f) { u32x4 o; o.x = cvt_pk_bf16(f[0], f[1]); o.y = cvt_pk_bf16(f[2], f[3]); o.z = cvt_pk_bf16(f[4], f[5]); o.w = cvt_pk_bf16(f[6], f[7]); return o; }
__device__ __forceinline__ float wave_sum(float v) {
#pragma unroll
    for (int o = 1; o < 64; o <<= 1) v += __shfl_xor(v, o);
    return v;
}
__device__ __forceinline__ float wave_max(float v) {
#pragma unroll
    for (int o = 1; o < 64; o <<= 1) v = fmaxf(v, __shfl_xor(v, o));
    return v;
}
__device__ __forceinline__ float silu_f(float x) { return x * __builtin_amdgcn_rcpf(1.f + __expf(-x)); }
__device__ __forceinline__ float sigmoid_f(float x) { return __builtin_amdgcn_rcpf(1.f + __expf(-x)); }
__device__ __forceinline__ int rowof(int b, int p) { return p < NMETA ? XROWS + p : b * SEQ + p - NMETA; }
__device__ __forceinline__ const bf16_t* proj_row(const unsigned char* ws, int r) {
    return (const bf16_t*)(ws + OFF_PROJ) + (size_t)r * PROJ_LD;
}

namespace pg8 {
constexpr int BM = 256, BK = 64, HALF = 128, HTB = HALF * BK * 2, NXCD = 8, WGM = 8;
__device__ __forceinline__ int lds_byte(int r, int c) { const int st = (r >> 4) * 2 + (c >> 5), rr = r & 15, cc = c & 31, ob = rr * 64 + cc * 2; return st * 1024 + (ob ^ (((ob >> 9) & 1) << 5)); }
__device__ __forceinline__ void stage_rc(int b, int& R, int& C) { const int st = b / 1024, sb = b % 1024, swz = sb ^ (((sb >> 9) & 1) << 5); R = (st >> 1) * 16 + swz / 64; C = (st & 1) * 32 + (swz % 64) / 2; }
__device__ __forceinline__ int perm32(int rho) { const int n = rho >> 4, i = rho & 15; return 8 * (i >> 2) + 4 * n + (i & 3); }

struct Unit { const char* A; const char* B; int nt; int pm; int pn; int kind; };

struct Sched {
    int nM, nN, nwg, G, c, parts, mt0, has_meta, nt0, nt1, pn_base, pn_last;
    const char *Ax, *Am, *B; size_t a_tile, b_tile, a_part1;
    __device__ bool next(int j, Unit& u) const {
        const int i = parts == 2 ? (j >> 1) : j, part = parts == 2 ? (j & 1) : 0;
        const long L = (long)i * G + c; if (L >= nwg) return false;
        int wgid = (int)L; { const int q = nwg / NXCD, r = nwg % NXCD, xcd = wgid % NXCD, off = wgid / NXCD; wgid = (xcd < r ? xcd * (q + 1) : r * (q + 1) + (xcd - r) * q) + off; }
        const int nig = WGM * nN, gid = wgid / nig, fm = gid * WGM, gsz = (nM - fm) < WGM ? (nM - fm) : WGM;
        const int pml = fm + ((wgid % nig) % gsz), pn = (wgid % nig) / gsz;
        const bool meta = has_meta && pml == nM - 1;
        const int pna = (pn_last >= 0 && pn == nN - 1) ? pn_last : pn_base + pn;
        u.pm = meta ? META_TILE : mt0 + pml; u.pn = pna;
        const size_t ko = part ? (size_t)nt0 * (BK * 2) : 0;
        u.A = (meta ? Am : Ax + (size_t)pml * a_tile) + (part ? a_part1 : 0); u.B = B + (size_t)pna * b_tile + ko;
        u.nt = part ? nt1 : nt0; u.kind = parts == 2 ? part + 1 : 0;
        return true;
    }
};

template <class Epi>
__device__ __forceinline__ void gemm_phase(LAS unsigned char* lds, const int lda, const int ldb, const Sched& S, const Epi& E) {
    const int tid = otid(), wid = __builtin_amdgcn_readfirstlane(tid >> 6), lane = tid & 63, wr = wid >> 2, wc = wid & 3, fr = lane & 15, fq = lane >> 4;
    unsigned voffA[2], voffB[2];
#pragma unroll
    for (int i = 0; i < 2; ++i) { int R, C; stage_rc(tid * 16 + i * 8192, R, C); const int Rb = (R & ~31) + perm32(R & 31);
        voffA[i] = (unsigned)(R * lda + C) * 2u; voffB[i] = (unsigned)(Rb * ldb + C) * 2u; }
    const size_t kstep = (size_t)(BK * 2);
    const size_t hstepA = (size_t)HALF * lda * 2, hstepB = (size_t)HALF * ldb * 2;
    const unsigned ldsw = (unsigned)wid * 1024u;
    const int aoff = lds_byte(wr * 64 + fr, fq * 8), boff = lds_byte(wc * 32 + fr, fq * 8);
#define PG8_SA(b, h) (((b) * 2 + (h)) * HTB)
#define PG8_SB(b, h) ((4 + (b) * 2 + (h)) * HTB)
#define PG8_STAGE(bufoff, gbase, voff) do { _Pragma("unroll") for (int _i = 0; _i < 2; ++_i) \
        __builtin_amdgcn_global_load_lds((const unsigned*)((const char*)(gbase) + (voff)[_i]), (LAS unsigned*)(lds + (bufoff) + ldsw + _i * 8192), 16, 0, 0); } while (0)
#define PG8_LDA(dst, b, h) do { _Pragma("unroll") for (int m = 0; m < 4; ++m) _Pragma("unroll") for (int k = 0; k < 2; ++k) dst[m][k] = *(const LAS bf16x8*)(lds + PG8_SA(b, h) + aoff + m * 2048 + k * 1024); } while (0)
#define PG8_LDB(dst, b, h) do { _Pragma("unroll") for (int n = 0; n < 2; ++n) _Pragma("unroll") for (int k = 0; k < 2; ++k) dst[n][k] = *(const LAS bf16x8*)(lds + PG8_SB(b, h) + boff + n * 2048 + k * 1024); } while (0)
#define PG8_MMA(ai, bj, At, Bt) do { __builtin_amdgcn_s_setprio(1); _Pragma("unroll") for (int m = 0; m < 4; ++m) _Pragma("unroll") for (int n = 0; n < 2; ++n) _Pragma("unroll") for (int k = 0; k < 2; ++k) \
        acc[ai][bj][m][n] = __builtin_amdgcn_mfma_f32_16x16x32_bf16(Bt[n][k], At[m][k], acc[ai][bj][m][n], 0, 0, 0); __builtin_amdgcn_s_setprio(0); } while (0)
#define PG8_WAIT_V(n) asm volatile("s_waitcnt vmcnt(" #n ")" ::: "memory")
#define PG8_WAIT_L(n) asm volatile("s_waitcnt lgkmcnt(" #n ")" ::: "memory")
#define PG8_BAR __builtin_amdgcn_s_barrier()
#define PG8_SCHED __builtin_amdgcn_sched_barrier(0)
    Unit cur, nxt; int ui = 0;
    if (!S.next(0, cur)) return;
    f32x4 acc[2][2][4][2];
#pragma unroll
    for (int a = 0; a < 2; ++a)
#pragma unroll
        for (int b = 0; b < 2; ++b)
#pragma unroll
            for (int m = 0; m < 4; ++m)
#pragma unroll
                for (int n = 0; n < 2; ++n) acc[a][b][m][n] = (f32x4){0.f, 0.f, 0.f, 0.f};
    bf16x8 At[4][2], B0[2][2], B1[2][2];
    const char* cA = cur.A; const char* cB = cur.B;
    PG8_STAGE(PG8_SB(0, 0), cB, voffB); PG8_STAGE(PG8_SA(0, 0), cA, voffA); PG8_STAGE(PG8_SB(0, 1), cB + hstepB, voffB); PG8_STAGE(PG8_SA(0, 1), cA + hstepA, voffA);
    if (wr == 1) PG8_BAR;
    PG8_WAIT_V(4); PG8_BAR;
    PG8_STAGE(PG8_SB(1, 0), cB + kstep, voffB); PG8_STAGE(PG8_SA(1, 0), cA + kstep, voffA); PG8_STAGE(PG8_SB(1, 1), cB + hstepB + kstep, voffB);
    PG8_WAIT_V(6); PG8_BAR;
    for (;;) {
        const bool has_next = S.next(ui + 1, nxt);
        const char* nA = has_next ? nxt.A : cA; const char* nB = has_next ? nxt.B : cB;
        const int nt = cur.nt;
        for (int t = 0; t < nt; t += 2) {
            const bool last = (t == nt - 2);
            const char* a1 = cA + (size_t)(t + 1) * kstep;
            const char* a2 = last ? nA : cA + (size_t)(t + 2) * kstep; const char* b2 = last ? nB : cB + (size_t)(t + 2) * kstep;
            const char* a3 = a2 + kstep; const char* b3 = b2 + kstep;
            PG8_LDB(B0, 0, 0); PG8_SCHED; PG8_LDA(At, 0, 0); PG8_STAGE(PG8_SA(1, 1), a1 + hstepA, voffA);
            PG8_WAIT_L(8); PG8_BAR; PG8_WAIT_L(0); PG8_MMA(0, 0, At, B0); PG8_BAR; PG8_SCHED;
            PG8_LDB(B1, 0, 1); PG8_STAGE(PG8_SB(0, 0), b2, voffB);
            PG8_BAR; PG8_WAIT_L(0); PG8_MMA(0, 1, At, B1); PG8_BAR;
            PG8_LDA(At, 0, 1); PG8_STAGE(PG8_SA(0, 0), a2, voffA);
            PG8_BAR; PG8_WAIT_L(0); PG8_MMA(1, 0, At, B0); PG8_BAR; PG8_SCHED;
            PG8_STAGE(PG8_SB(0, 1), b2 + hstepB, voffB);
            PG8_WAIT_V(6); PG8_BAR; PG8_MMA(1, 1, At, B1); PG8_BAR;
            PG8_LDB(B0, 1, 0); PG8_SCHED; PG8_LDA(At, 1, 0); PG8_STAGE(PG8_SA(0, 1), a2 + hstepA, voffA);
            PG8_WAIT_L(8); PG8_BAR; PG8_WAIT_L(0); PG8_MMA(0, 0, At, B0); PG8_BAR; PG8_SCHED;
            PG8_LDB(B1, 1, 1); PG8_STAGE(PG8_SB(1, 0), b3, voffB);
            PG8_BAR; PG8_WAIT_L(0); PG8_MMA(0, 1, At, B1); PG8_BAR;
            PG8_LDA(At, 1, 1); PG8_STAGE(PG8_SA(1, 0), a3, voffA);
            PG8_BAR; PG8_WAIT_L(0); PG8_MMA(1, 0, At, B0); PG8_BAR; PG8_SCHED;
            PG8_STAGE(PG8_SB(1, 1), b3 + hstepB, voffB);
            PG8_WAIT_V(6); PG8_BAR; PG8_MMA(1, 1, At, B1); PG8_BAR;
        }
        E(acc, cur, wr, wc, fr, fq);
        if (!has_next) break;
        if (cur.kind != 1) {
#pragma unroll
            for (int a = 0; a < 2; ++a)
#pragma unroll
                for (int b = 0; b < 2; ++b)
#pragma unroll
                    for (int m = 0; m < 4; ++m)
#pragma unroll
                        for (int n = 0; n < 2; ++n) acc[a][b][m][n] = (f32x4){0.f, 0.f, 0.f, 0.f};
        }
        cur = nxt; cA = nA; cB = nB; ++ui;
    }
    PG8_WAIT_V(0);
    if (wr == 0) PG8_BAR;
    PG8_BAR;
#undef PG8_SA
#undef PG8_SB
#undef PG8_STAGE
#undef PG8_LDA
#undef PG8_LDB
#undef PG8_MMA
#undef PG8_WAIT_V
#undef PG8_WAIT_L
#undef PG8_BAR
#undef PG8_SCHED
}
}
using pg8::Unit;
typedef f32x4 Acc[2][2][4][2];

__device__ __forceinline__ float dpp_prev1(float cur, float prev) {
    const int o = __builtin_amdgcn_mov_dpp(__builtin_bit_cast(int, prev), 0x121, 0xf, 0xf, false);
    return __builtin_bit_cast(float, __builtin_amdgcn_update_dpp(o, __builtin_bit_cast(int, cur), 0x111, 0xf, 0xf, false));
}
__device__ __forceinline__ float dpp_prev2(float cur, float prev) {
    const int o = __builtin_amdgcn_mov_dpp(__builtin_bit_cast(int, prev), 0x122, 0xf, 0xf, false);
    return __builtin_bit_cast(float, __builtin_amdgcn_update_dpp(o, __builtin_bit_cast(int, cur), 0x112, 0xf, 0xf, false));
}
__device__ __forceinline__ float dpp_prev3(float cur, float prev) {
    const int o = __builtin_amdgcn_mov_dpp(__builtin_bit_cast(int, prev), 0x123, 0xf, 0xf, false);
    return __builtin_bit_cast(float, __builtin_amdgcn_update_dpp(o, __builtin_bit_cast(int, cur), 0x113, 0xf, 0xf, false));
}
struct EpiG1 {
    unsigned char* ws; const float* dt_bias; const float* cw; const float* cb;
    __device__ __forceinline__ void operator()(Acc& acc, const Unit& u, int wr, int wc, int fr, int fq) const {
        if (u.pn >= 8 && u.pn < 20) {
#pragma unroll
            for (int bj = 0; bj < 2; ++bj) {
                const int ch = 256 * (u.pn - 8) + 128 * bj + 32 * wc + 8 * fq;
                float wv[5][8];
#pragma unroll
                for (int h = 0; h < 2; ++h) { const f32x4 b0 = *(const f32x4*)(cb + ch + 4 * h);
#pragma unroll
                    for (int j = 0; j < 4; ++j) wv[4][4 * h + j] = b0[j];
#pragma unroll
                    for (int k = 0; k < 4; ++k) { const f32x4 a0 = *(const f32x4*)(cw + k * 3072 + ch + 4 * h);
#pragma unroll
                        for (int j = 0; j < 4; ++j) wv[k][4 * h + j] = a0[j]; } }
#pragma unroll
                for (int ai = 0; ai < 2; ++ai)
#pragma unroll
                    for (int m = 0; m < 4; ++m) {
                        const int lr = 128 * ai + 64 * wr + 16 * m + fr, grow = u.pm * 256 + lr;
                        float o[8], rw[8];
#pragma unroll
                        for (int j = 0; j < 8; ++j) { const float c0 = acc[ai][bj][m][j >> 2][j & 3], pv = acc[ai][bj][m > 0 ? m - 1 : 0][j >> 2][j & 3];
                            const float v = wv[4][j] + wv[3][j] * c0 + wv[2][j] * dpp_prev1(c0, pv) + wv[1][j] * dpp_prev2(c0, pv) + wv[0][j] * dpp_prev3(c0, pv);
                            o[j] = silu_f(v); rw[j] = c0; }
                        *(u32x4*)((bf16_t*)(ws + OFF_PROJ) + (size_t)grow * PROJ_LD + C_XS + ch) = pack8(o);
                        if (m == 0 || m == 3) {
                            const bool top = m == 0 && fr < 3, bot = m == 3 && fr >= 13;
                            if (top || bot) *(u32x4*)((bf16_t*)(ws + OFF_RAW1) + (size_t)((grow >> 6) * 6 + (top ? 3 + fr : fr - 13)) * 3072 + ch) = pack8(rw);
                            if (m == 0 && u.pm == META_TILE && ai == 0 && wr == 0 && fr >= 13) *(u32x4*)((bf16_t*)(ws + OFF_RAW1M) + (size_t)(fr - 13) * 3072 + ch) = pack8(rw);
                        }
                    }
            }
            return;
        }
#pragma unroll
        for (int ai = 0; ai < 2; ++ai)
#pragma unroll
            for (int m = 0; m < 4; ++m) {
                const int lr = 128 * ai + 64 * wr + 16 * m + fr;
                if (u.pn < 34) {
                    bf16_t* rp = (bf16_t*)(ws + OFF_PROJ) + (size_t)(u.pm * 256 + lr) * PROJ_LD + (u.pn < 26 ? 256 * u.pn : C_GS + 256 * (u.pn - 26)) + 32 * wc + 8 * fq;
#pragma unroll
                    for (int bj = 0; bj < 2; ++bj) { u32x4 o; o.x = cvt_pk_bf16(acc[ai][bj][m][0][0], acc[ai][bj][m][0][1]); o.y = cvt_pk_bf16(acc[ai][bj][m][0][2], acc[ai][bj][m][0][3]);
                        o.z = cvt_pk_bf16(acc[ai][bj][m][1][0], acc[ai][bj][m][1][1]); o.w = cvt_pk_bf16(acc[ai][bj][m][1][2], acc[ai][bj][m][1][3]); *(u32x4*)(rp + 128 * bj) = o;
 }
                } else if (wc == 0) {
                    float* dp = (float*)(ws + OFF_DT) + (size_t)(u.pm * 256 + lr) * 32 + 8 * fq;
                    f32x4 d0, d1;
#pragma unroll
                    for (int j = 0; j < 4; ++j) { const float x0 = acc[ai][0][m][0][j] + dt_bias[8 * fq + j], x1 = acc[ai][0][m][1][j] + dt_bias[8 * fq + 4 + j];
                        d0[j] = fmaxf(x0, 0.f) + __logf(1.f + __expf(-fabsf(x0))); d1[j] = fmaxf(x1, 0.f) + __logf(1.f + __expf(-fabsf(x1))); }
                    *(f32x4*)dp = d0; *(f32x4*)(dp + 4) = d1;
                }
            }
    }
};
struct EpiG2 {
    unsigned char* ws; bf16_t* mbuf_x;
    __device__ __forceinline__ void operator()(Acc& acc, const Unit& u, int wr, int wc, int fr, int fq) const {
#pragma unroll
        for (int ai = 0; ai < 2; ++ai)
#pragma unroll
            for (int m = 0; m < 4; ++m) {
                const int lr = 128 * ai + 64 * wr + 16 * m + fr, grow = u.pm * 256 + lr, c8 = 256 * u.pn + 32 * wc + 8 * fq;
                const bf16_t* pr = proj_row(ws, grow);
                if (u.kind == 1) {
                    const f32x4* sq = (const f32x4*)((const float*)(ws + OFF_SSQ) + (size_t)grow * 32);
                    float s = 0.f;
#pragma unroll
                    for (int i = 0; i < 8; ++i) { const f32x4 v = sq[i]; s += (v[0] + v[1]) + (v[2] + v[3]); }
                    const float rs = rsqrtf(s * (1.f / 2048.f) + EPS);
#pragma unroll
                    for (int bj = 0; bj < 2; ++bj) {
                        float gs[8], ga[8]; unpack8(*(const u32x4*)(pr + C_GS + c8 + 128 * bj), gs); unpack8(*(const u32x4*)(pr + C_GA + c8 + 128 * bj), ga);
#pragma unroll
                        for (int j = 0; j < 8; ++j) { const float a = fminf(fmaxf(ga[j], -60.f), 60.f), g = fminf(fmaxf(gs[j], -60.f), 60.f);
                            acc[ai][bj][m][j >> 2][j & 3] *= rs * (1.f + __expf(-a)) * __builtin_amdgcn_rcpf(1.f + __expf(-g)); }
                    }
                } else {
                    bf16_t* op = (u.pm == META_TILE ? (bf16_t*)(ws + OFF_MBUF_META) + (size_t)lr * D : mbuf_x + (size_t)grow * D) + c8;
#pragma unroll
                    for (int bj = 0; bj < 2; ++bj) {
                        float ga[8], o[8]; unpack8(*(const u32x4*)(pr + C_GA + c8 + 128 * bj), ga);
#pragma unroll
                        for (int j = 0; j < 8; ++j) { const float a = fminf(fmaxf(ga[j], -60.f), 60.f); o[j] = acc[ai][bj][m][j >> 2][j & 3] * __builtin_amdgcn_rcpf(1.f + __expf(-a)); }
                        *(u32x4*)(op + 128 * bj) = pack8(o);
                    }
                }
            }
    }
};
struct EpiF32 {
    float* C;
    __device__ __forceinline__ void operator()(Acc& acc, const Unit& u, int wr, int wc, int fr, int fq) const {
#pragma unroll
        for (int ai = 0; ai < 2; ++ai)
#pragma unroll
            for (int m = 0; m < 4; ++m) {
                float* rp = C + (size_t)(u.pm * 256 + 128 * ai + 64 * wr + 16 * m + fr) * D + 256 * u.pn + 32 * wc + 8 * fq;
#pragma unroll
                for (int bj = 0; bj < 2; ++bj) { *(f32x4*)(rp + 128 * bj) = acc[ai][bj][m][0]; *(f32x4*)(rp + 128 * bj + 4) = acc[ai][bj][m][1]; }
            }
    }
};
struct EpiB16 {
    bf16_t* C;
    __device__ __forceinline__ void operator()(Acc& acc, const Unit& u, int wr, int wc, int fr, int fq) const {
#pragma unroll
        for (int ai = 0; ai < 2; ++ai)
#pragma unroll
            for (int m = 0; m < 4; ++m) {
                bf16_t* rp = C + (size_t)(u.pm * 256 + 128 * ai + 64 * wr + 16 * m + fr) * D + 256 * u.pn + 32 * wc + 8 * fq;
#pragma unroll
                for (int bj = 0; bj < 2; ++bj) { u32x4 o; o.x = cvt_pk_bf16(acc[ai][bj][m][0][0], acc[ai][bj][m][0][1]); o.y = cvt_pk_bf16(acc[ai][bj][m][0][2], acc[ai][bj][m][0][3]);
                    o.z = cvt_pk_bf16(acc[ai][bj][m][1][0], acc[ai][bj][m][1][1]); o.w = cvt_pk_bf16(acc[ai][bj][m][1][2], acc[ai][bj][m][1][3]); *(u32x4*)(rp + 128 * bj) = o; }
            }
    }
};
struct EpiG4F {
    bf16_t* act; bf16_t* raw; const float* cw; const float* cb;
    __device__ __forceinline__ void operator()(Acc& acc, const Unit& u, int wr, int wc, int fr, int fq) const {
        const int c8 = 128 * u.pn + 32 * wc + 8 * fq;
        float wa[3][8], wg[3][8], ba[8], bg[8];
#pragma unroll
        for (int h = 0; h < 2; ++h) {
            const f32x4 b0 = *(const f32x4*)(cb + c8 + 4 * h), b1 = *(const f32x4*)(cb + FF + c8 + 4 * h);
#pragma unroll
            for (int j = 0; j < 4; ++j) { ba[4 * h + j] = b0[j]; bg[4 * h + j] = b1[j]; }
#pragma unroll
            for (int k = 0; k < 3; ++k) { const f32x4 a0 = *(const f32x4*)(cw + k * U_LD + c8 + 4 * h), g0 = *(const f32x4*)(cw + k * U_LD + FF + c8 + 4 * h);
#pragma unroll
                for (int j = 0; j < 4; ++j) { wa[k][4 * h + j] = a0[j]; wg[k][4 * h + j] = g0[j]; } }
        }
#pragma unroll
        for (int ai = 0; ai < 2; ++ai)
#pragma unroll
            for (int m = 0; m < 4; ++m) {
                const int lr = 128 * ai + 64 * wr + 16 * m + fr, grow = u.pm * 256 + lr;
                float o[8], ra[8], rg[8];
#pragma unroll
                for (int j = 0; j < 8; ++j) {
                    const float ca = acc[ai][0][m][j >> 2][j & 3], cg = acc[ai][1][m][j >> 2][j & 3];
                    const float pa = acc[ai][0][m > 0 ? m - 1 : 0][j >> 2][j & 3], pg = acc[ai][1][m > 0 ? m - 1 : 0][j >> 2][j & 3];
                    const float a1 = dpp_prev1(ca, pa), a2 = dpp_prev2(ca, pa), g1 = dpp_prev1(cg, pg), g2 = dpp_prev2(cg, pg);
                    const float va = ba[j] + wa[2][j] * ca + wa[1][j] * a1 + wa[0][j] * a2;
                    const float vg = bg[j] + wg[2][j] * cg + wg[1][j] * g1 + wg[0][j] * g2;
                    o[j] = silu_f(va) * vg; ra[j] = ca; rg[j] = cg;
                }
                *(u32x4*)(act + (size_t)grow * FF + c8) = pack8(o);
                if (m == 0 || m == 3) {
                    const bool top = m == 0 && fr < 2, bot = m == 3 && fr >= 14;
                    if (top || bot) { bf16_t* rp = raw + (size_t)((grow >> 6) * 4 + (top ? 2 + fr : fr - 14)) * U_LD + c8;
                        *(u32x4*)rp = pack8(ra); *(u32x4*)(rp + FF) = pack8(rg); }
                }
            }
    }
};
__device__ __forceinline__ void ffn_fixup(const Params& p, int pm) {
    const int t = otid();
    bf16_t* act = (bf16_t*)(p.ws + OFF_U); const bf16_t* raw = (const bf16_t*)(p.ws + OFF_RAW); const bf16_t* rawm = (const bf16_t*)(p.ws + OFF_RAWM);
    const float* cw = p.in[17]; const float* cb = p.in[18];
    for (int task = t; task < 4 * 352; task += 512) {
        const int q = task / 352, c = (task % 352) * 8, g = pm * 4 + q, R = g * 64;
        const bf16_t* cur = raw + (size_t)(g * 4 + 2) * U_LD;
        const bf16_t* prv = (R & 4095) == 0 ? rawm : raw + (size_t)((g - 1) * 4) * U_LD;
        float a[4][8], gg[4][8];
        unpack8(*(const u32x4*)(prv + c), a[0]); unpack8(*(const u32x4*)(prv + U_LD + c), a[1]); unpack8(*(const u32x4*)(cur + c), a[2]); unpack8(*(const u32x4*)(cur + U_LD + c), a[3]);
        unpack8(*(const u32x4*)(prv + FF + c), gg[0]); unpack8(*(const u32x4*)(prv + U_LD + FF + c), gg[1]); unpack8(*(const u32x4*)(cur + FF + c), gg[2]); unpack8(*(const u32x4*)(cur + U_LD + FF + c), gg[3]);
#pragma unroll
        for (int i = 0; i < 2; ++i) { float o[8];
#pragma unroll
            for (int j = 0; j < 8; ++j) {
                const float va = cb[c + j] + cw[2 * U_LD + c + j] * a[i + 2][j] + cw[U_LD + c + j] * a[i + 1][j] + cw[c + j] * a[i][j];
                const float vg = cb[FF + c + j] + cw[2 * U_LD + FF + c + j] * gg[i + 2][j] + cw[U_LD + FF + c + j] * gg[i + 1][j] + cw[FF + c + j] * gg[i][j];
                o[j] = silu_f(va) * vg; }
            *(u32x4*)(act + (size_t)(R + i) * FF + c) = pack8(o); }
    }
}
struct EpiG4 {
    bf16_t* U; bf16_t* halo;
    __device__ __forceinline__ void operator()(Acc& acc, const Unit& u, int wr, int wc, int fr, int fq) const {
#pragma unroll
        for (int ai = 0; ai < 2; ++ai)
#pragma unroll
            for (int m = 0; m < 4; ++m) {
                const int lr = 128 * ai + 64 * wr + 16 * m + fr, col = 256 * u.pn + 32 * wc + 8 * fq;
                bf16_t* rp = U + (size_t)(u.pm * 256 + lr) * U_LD + col;
                const bool h = (u.pm == META_TILE) ? (lr == 14 || lr == 15) : (lr >= 254);
                bf16_t* hp = halo + (size_t)(u.pm * 2 + (lr & 1)) * U_LD + col;
#pragma unroll
                for (int bj = 0; bj < 2; ++bj) { u32x4 o; o.x = cvt_pk_bf16(acc[ai][bj][m][0][0], acc[ai][bj][m][0][1]); o.y = cvt_pk_bf16(acc[ai][bj][m][0][2], acc[ai][bj][m][0][3]);
                    o.z = cvt_pk_bf16(acc[ai][bj][m][1][0], acc[ai][bj][m][1][1]); o.w = cvt_pk_bf16(acc[ai][bj][m][1][2], acc[ai][bj][m][1][3]); *(u32x4*)(rp + 128 * bj) = o;
                    if (h) *(u32x4*)(hp + 128 * bj) = o; }
            }
    }
};

__device__ __forceinline__ void tr_item(const float* W, int ldn, int k0, int n0src, bool zero, const float* kscale, bf16_t* WT, int ldk, int nrow0, int kcol0, LAS float* scr, int lane) {
#pragma unroll
    for (int i = 0; i < 32; ++i) { const int kk = 2 * i + (lane >> 5); float v = zero ? 0.f : __builtin_nontemporal_load(W + (size_t)(k0 + kk) * ldn + n0src + (lane & 31)); if (kscale) v *= kscale[k0 + kk]; scr[kk * 33 + (lane & 31)] = v; }
    asm volatile("s_waitcnt lgkmcnt(0)" ::: "memory");
    const int c = lane & 7;
#pragma unroll
    for (int j = 0; j < 4; ++j) { const int n = (lane >> 3) + 8 * j; const LAS float* s = scr + (8 * c) * 33 + n;
        u32x4 o; o.x = cvt_pk_bf16(s[0 * 33], s[1 * 33]); o.y = cvt_pk_bf16(s[2 * 33], s[3 * 33]); o.z = cvt_pk_bf16(s[4 * 33], s[5 * 33]); o.w = cvt_pk_bf16(s[6 * 33], s[7 * 33]);
        *(u32x4*)(WT + (size_t)(nrow0 + n) * ldk + kcol0 + k0 + 8 * c) = o; }
    asm volatile("s_waitcnt lgkmcnt(0)" ::: "memory");
}
__device__ __forceinline__ void phase_prep(const Params& p, LAS unsigned char* lds) {
    const int tid_ = otid(), lane = tid_ & 63, wave = tid_ >> 6, gw = obid() * 8 + wave, NGW = gridDim.x * 8;
    LAS float* scr = (LAS float*)(lds + wave * 8448);
    constexpr int I_IN = 280 * 16, I_SSM = 32 * 32, I_AT = 16 * 32, I_MIX = 16 * 32, I_UP = 16 * 176, I_DN = 44 * 32;
    constexpr int NIT = I_IN + I_SSM + I_AT + I_MIX + I_UP + I_DN;
    for (int it = gw; it < NIT; it += NGW) {
        int r = it;
        if (r < I_IN) { const int nb = r % 280, kb = r / 280; const int srcb = nb < 160 ? nb : (nb < 272 ? nb + 1 : 160);
            tr_item(p.in[3], 8736, 64 * kb, 32 * srcb, nb > 272, nullptr, (bf16_t*)(p.ws + OFF_WIN), 1024, 32 * nb, 0, scr, lane); continue; } r -= I_IN;
        if (r < I_SSM) { const int nb = r % 32, kb = r / 32; tr_item(p.in[10], 1024, 64 * kb, 32 * nb, false, p.in[9], (bf16_t*)(p.ws + OFF_WG2), 3072, 32 * nb, 0, scr, lane); continue; } r -= I_SSM;
        if (r < I_AT) { const int nb = r % 32, kb = r / 32; tr_item(p.in[12], 1024, 64 * kb, 32 * nb, false, nullptr, (bf16_t*)(p.ws + OFF_WG2), 3072, 32 * nb, 2048, scr, lane); continue; } r -= I_AT;
        if (r < I_MIX) { const int nb = r % 32, kb = r / 32; tr_item(p.in[13], 1024, 64 * kb, 32 * nb, false, nullptr, (bf16_t*)(p.ws + OFF_WMIX), 1024, 32 * nb, 0, scr, lane); continue; } r -= I_MIX;
        if (r < I_UP) { const int nb = r % 176, kb = r / 176; const int srcc = ((nb & 4) ? FF : 0) + 128 * (nb >> 3) + 32 * (nb & 3);
            tr_item(p.in[16], 5632, 64 * kb, srcc, false, nullptr, (bf16_t*)(p.ws + OFF_WUP), 1024, 32 * nb, 0, scr, lane); continue; } r -= I_UP;
        { const int nb = r % 32, kb = r / 32; tr_item(p.in[19], 1024, 64 * kb, 32 * nb, false, nullptr, (bf16_t*)(p.ws + OFF_WDN), 2816, 32 * nb, 0, scr, lane); }
    }
    const float* w = p.in[2];
    f32x4 wv[4];
#pragma unroll
    for (int j = 0; j < 4; ++j) wv[j] = *(const f32x4*)(w + (lane + 64 * j) * 4);
    for (int r0 = gw; r0 < MROWS; r0 += 4 * NGW) {
        f32x4 v[4][4];
#pragma unroll
        for (int i = 0; i < 4; ++i) { const int r = r0 + i * NGW; const bool real = r < XROWS + NMETA;
            const float* src = r < XROWS ? p.in[0] + (size_t)r * D : p.in[1] + (size_t)(real ? r - XROWS : 0) * D;
#pragma unroll
            for (int j = 0; j < 4; ++j) v[i][j] = __builtin_nontemporal_load((const f32x4*)(src + (lane + 64 * j) * 4)); }
#pragma unroll
        for (int i = 0; i < 4; ++i) { const int r = r0 + i * NGW;
            if (r >= MROWS) continue;
            const bool real = r < XROWS + NMETA;
            bf16_t* dst = r < XROWS ? (bf16_t*)p.out + (size_t)r * D : (bf16_t*)(p.ws + OFF_HN_META) + (size_t)(r - XROWS) * D;
            float s = 0.f;
#pragma unroll
            for (int j = 0; j < 4; ++j) s += (v[i][j][0] * v[i][j][0] + v[i][j][1] * v[i][j][1]) + (v[i][j][2] * v[i][j][2] + v[i][j][3] * v[i][j][3]);
            const float rs = real ? rsqrtf(wave_sum(s) * (1.f / D) + EPS) : 0.f;
#pragma unroll
            for (int j = 0; j < 4; ++j) { u32x2 o; o.x = cvt_pk_bf16(v[i][j][0] * rs * wv[j][0], v[i][j][1] * rs * wv[j][1]); o.y = cvt_pk_bf16(v[i][j][2] * rs * wv[j][2], v[i][j][3] * rs * wv[j][3]);
                *(u32x2*)(dst + (lane + 64 * j) * 4) = o; }
        }
    }
}

__device__ __forceinline__ unsigned bf_pair(unsigned x, unsigned y, int j) { const unsigned a = (j & 1) ? (x >> 16) : (x & 0xffffu), c = (j & 1) ? (y & 0xffff0000u) : (y << 16); return a | c; }
__device__ __forceinline__ int ssd_pos(int c, int tk) { return c == 0 ? tk - 48 : 16 + (c - 1) * 64 + tk; }
__device__ __forceinline__ void ssd_load4(const unsigned char* ws, int b, int c, int tg, int col, u32x4 (&raw)[4]) {
#pragma unroll
    for (int k = 0; k < 4; ++k) { const int pos = ssd_pos(c, 4 * tg + k);
        const u32x4 v = *(const u32x4*)(proj_row(ws, rowof(b, pos < 0 ? 0 : pos)) + col); const unsigned m = pos >= 0 ? 0xffffffffu : 0u;
        raw[k] = (u32x4){v.x & m, v.y & m, v.z & m, v.w & m}; }
}
__device__ __forceinline__ void ssd_load2(const unsigned char* ws, int b, int c, int tp, int col, u32x2 (&raw)[2]) {
#pragma unroll
    for (int k = 0; k < 2; ++k) { const int pos = ssd_pos(c, 2 * tp + k);
        const u32x2 v = *(const u32x2*)(proj_row(ws, rowof(b, pos < 0 ? 0 : pos)) + col); const unsigned m = pos >= 0 ? 0xffffffffu : 0u;
        raw[k] = (u32x2){v.x & m, v.y & m}; }
}
__device__ __forceinline__ float ssd_loaddt(const unsigned char* ws, int b, int c, int lane, int head) {
    const int pos = ssd_pos(c, lane); return ((const float*)(ws + OFF_DT))[(size_t)rowof(b, pos < 0 ? 0 : pos) * 32 + head];
}
#define FRAG(base, stride, row, kel) (*(const LAS bf16x8*)((base) + (row) * (stride) + (kel) * 2))
__device__ __forceinline__ void ssm_fixup(const Params& p, int b, int head) {
    unsigned char* ws = p.ws;
    const int t = otid(), grp = head >> 3;
    const bf16_t* raw = (const bf16_t*)(ws + OFF_RAW1); const bf16_t* rawm = (const bf16_t*)(ws + OFF_RAW1M);
    const float* cw = p.in[4]; const float* cb = p.in[5];
    for (int task = t; task < 65 * 40; task += 512) {
        const int q = task / 40, cgp = task % 40, g = q < 64 ? b * 64 + q : 512;
        const int ch = cgp < 8 ? head * 64 + cgp * 8 : (cgp < 24 ? 2048 + grp * 128 + (cgp - 8) * 8 : 2560 + grp * 128 + (cgp - 24) * 8);
        float u[6][8];
        const bool zero_prev = g == 512, from_meta = !zero_prev && (g & 63) == 0;
        const bf16_t* prv = from_meta ? rawm : raw + (size_t)((zero_prev ? g : g - 1) * 6) * 3072;
#pragma unroll
        for (int k = 0; k < 3; ++k) { unpack8(*(const u32x4*)(prv + (size_t)k * 3072 + ch), u[k]);
            if (zero_prev) {
#pragma unroll
                for (int j = 0; j < 8; ++j) u[k][j] = 0.f; } }
#pragma unroll
        for (int k = 0; k < 3; ++k) unpack8(*(const u32x4*)(raw + (size_t)(g * 6 + 3 + k) * 3072 + ch), u[3 + k]);
        float wv[5][8];
#pragma unroll
        for (int h = 0; h < 2; ++h) { const f32x4 b0 = *(const f32x4*)(cb + ch + 4 * h);
#pragma unroll
            for (int j = 0; j < 4; ++j) wv[4][4 * h + j] = b0[j];
#pragma unroll
            for (int k = 0; k < 4; ++k) { const f32x4 a0 = *(const f32x4*)(cw + k * 3072 + ch + 4 * h);
#pragma unroll
                for (int j = 0; j < 4; ++j) wv[k][4 * h + j] = a0[j]; } }
#pragma unroll
        for (int i = 0; i < 3; ++i) { float o[8];
#pragma unroll
            for (int j = 0; j < 8; ++j) { float v = wv[4][j];
#pragma unroll
                for (int k = 0; k < 4; ++k) v += wv[k][j] * u[i + k][j];
                o[j] = silu_f(v); }
            *(u32x4*)((bf16_t*)(ws + OFF_PROJ) + (size_t)(g * 64 + i) * PROJ_LD + C_XS + ch) = pack8(o); }
    }
    asm volatile("s_waitcnt vmcnt(0)" ::: "memory");
}
__device__ __forceinline__ void ssd_item(const Params& p, LAS unsigned char* lds, int b, int head) {
    ssm_fixup(p, b, head);
    unsigned char* ws = p.ws;
    const int tq = otid(), w = __builtin_amdgcn_readfirstlane(tq >> 6), grp = head >> 3, wp = w & 3, wl = w >> 2;
    LAS unsigned char* C_rm = lds;
    LAS unsigned char* B_rm = lds + 17408;
    LAS unsigned char* h_bf = lds + 34816;
    LAS unsigned char* BT = lds + 52224;
    LAS unsigned char* xdtT = lds + 70656;
    LAS unsigned char* M_s = lds + 79872;
    LAS unsigned char* xs_rm = lds + 89088;
    LAS unsigned char* xdtwT = lds + 98304;
    LAS float* dt_s2 = (LAS float*)(lds + 107520);
    LAS float* cs_s2 = dt_s2 + 128;
    LAS float* ssq_s = cs_s2 + 128;
    LAS float* cw_s = ssq_s + 256;
    const float Aneg = -__expf(p.in[7][head]), Dsk = p.in[8][head];
    __syncthreads();
    for (int i = tq; i < 17408 / 4; i += 512) ((LAS unsigned*)h_bf)[i] = 0u;
#ifndef SSD_RELAUNDER
#define SSD_RELAUNDER 0
#endif
#if SSD_RELAUNDER
#define SSD_LAUNDER(v) asm volatile("" : "+v"(v));
#else
#define SSD_LAUNDER(v)
#endif
#define SSD_LANE_VARS(tsrc) \
    int t = (tsrc); SSD_LAUNDER(t) \
    const int lane = t & 63, fr = lane & 15, fq = lane >> 4; \
    const bool isB = t < 256; const int t0 = isB ? t : t - 256, tg0 = t0 >> 4, cg0 = t0 & 15; \
    const int col0 = C_XS + (isB ? 2048 : 2560) + grp * 128 + 8 * cg0; \
    const int tp1 = t >> 4, cq1 = t & 15, col1 = C_XS + head * 64 + 4 * cq1;
    u32x4 raw0A[4], raw0B[4]; u32x2 raw1A[2], raw1B[2], zA[2], zB[2]; float dtA = 0.f, dtB = 0.f;
    { SSD_LANE_VARS(tq)
    ssd_load4(ws, b, 0, tg0, col0, raw0A); ssd_load2(ws, b, 0, tp1, col1, raw1A); dtA = ssd_loaddt(ws, b, 0, lane, head);
    ssd_load4(ws, b, 1, tg0, col0, raw0B); ssd_load2(ws, b, 1, tp1, col1, raw1B); dtB = ssd_loaddt(ws, b, 1, lane, head);
#pragma unroll
    for (int i = 0; i < 2; ++i) { const int p0 = ssd_pos(0, 16 * (2 * wl + i) + fr), p1 = ssd_pos(1, 16 * (2 * wl + i) + fr);
        zA[i] = *(const u32x2*)(proj_row(ws, rowof(b, p0 < 0 ? 0 : p0)) + C_Z + head * 64 + 16 * wp + 4 * fq);
        zB[i] = *(const u32x2*)(proj_row(ws, rowof(b, p1 < 0 ? 0 : p1)) + C_Z + head * 64 + 16 * wp + 4 * fq); } }
    f32x4 acc_h[4];
#pragma unroll
    for (int q = 0; q < 4; ++q) acc_h[q] = (f32x4){0.f, 0.f, 0.f, 0.f};
    __syncthreads();
    auto scan = [&](const int c, const float dtv) __attribute__((always_inline)) {
        const int lane = tq & 63;
        const bool ok = ssd_pos(c, lane) >= 0;
        const float dt = ok ? dtv : 0.f; float a = dt * Aneg;
        a += __builtin_bit_cast(float, __builtin_amdgcn_update_dpp(0, __builtin_bit_cast(int, a), 0x111, 0xf, 0xf, false));
        a += __builtin_bit_cast(float, __builtin_amdgcn_update_dpp(0, __builtin_bit_cast(int, a), 0x112, 0xf, 0xf, false));
        a += __builtin_bit_cast(float, __builtin_amdgcn_update_dpp(0, __builtin_bit_cast(int, a), 0x114, 0xf, 0xf, false));
        a += __builtin_bit_cast(float, __builtin_amdgcn_update_dpp(0, __builtin_bit_cast(int, a), 0x118, 0xf, 0xf, false));
        a += __builtin_bit_cast(float, __builtin_amdgcn_update_dpp(0, __builtin_bit_cast(int, a), 0x142, 0xa, 0xf, false));
        a += __builtin_bit_cast(float, __builtin_amdgcn_update_dpp(0, __builtin_bit_cast(int, a), 0x143, 0xc, 0xf, false));
        dt_s2[(c & 1) * 64 + lane] = dt; cs_s2[(c & 1) * 64 + lane] = a;
    };
    if (w == 0) scan(0, dtA);
    __syncthreads();
    auto chunk = [&](const int c, u32x4 (&raw0)[4], u32x2 (&raw1)[2], u32x2 (&zraw)[2], float& dtraw, const float& dt_next) __attribute__((always_inline)) {
        SSD_LANE_VARS(tq)
        LAS float* dt_s = dt_s2 + (c & 1) * 64; LAS float* cs_s = cs_s2 + (c & 1) * 64;
        const int cn = c + 2 < 65 ? c + 2 : 64;
        int yrow[2];
#pragma unroll
        for (int i = 0; i < 2; ++i) { const int pos = ssd_pos(c, 16 * (2 * wl + i) + fr); const bool ok = pos >= 0 && (pos >= NMETA || b == 0); yrow[i] = ok ? rowof(b, pos) : XROWS + 255; }
        const int rowc = b * SEQ + (cn - 1) * 64;
        const bf16_t* pc = (const bf16_t*)(ws + OFF_PROJ) + (size_t)rowc * PROJ_LD;
        dtraw = ((const float*)(ws + OFF_DT))[(size_t)(rowc + lane) * 32 + head];
        {
#pragma unroll
            for (int i = 0; i < 4; ++i) *(LAS u32x4*)((isB ? B_rm : C_rm) + (4 * tg0 + i) * 272 + cg0 * 16) = raw0[i];
            if (isB) {
#pragma unroll
                for (int j = 0; j < 8; ++j) { u32x2 o; o.x = bf_pair(raw0[0][j >> 1], raw0[1][j >> 1], j); o.y = bf_pair(raw0[2][j >> 1], raw0[3][j >> 1], j);
                    *(LAS u32x2*)(BT + (8 * cg0 + j) * 144 + (tg0 ^ (cg0 & 14)) * 8) = o; } }
#pragma unroll
            for (int k = 0; k < 4; ++k) raw0[k] = *(const u32x4*)(pc + (4 * tg0 + k) * PROJ_LD + col0);
        }
        const float cs_last = cs_s[63];
        {
            float xv[2][4];
#pragma unroll
            for (int i = 0; i < 2; ++i) { const u32x2 r = raw1[i];
                xv[i][0] = __uint_as_float(r.x << 16); xv[i][1] = __uint_as_float(r.x & 0xffff0000u); xv[i][2] = __uint_as_float(r.y << 16); xv[i][3] = __uint_as_float(r.y & 0xffff0000u);
                *(LAS u32x2*)(xs_rm + (2 * tp1 + i) * 144 + cq1 * 8) = r; }
            const float d0 = dt_s[2 * tp1], d1 = dt_s[2 * tp1 + 1], w0 = d0 * __expf(cs_last - cs_s[2 * tp1]), w1 = d1 * __expf(cs_last - cs_s[2 * tp1 + 1]);
#pragma unroll
            for (int j = 0; j < 4; ++j) {
                *(LAS unsigned*)(xdtT + (4 * cq1 + j) * 144 + (tp1 ^ (4 * ((cq1 >> 1) & 7))) * 4) = cvt_pk_bf16(xv[0][j] * d0, xv[1][j] * d1);
                *(LAS unsigned*)(xdtwT + (4 * cq1 + j) * 144 + (tp1 ^ (4 * ((cq1 >> 1) & 7))) * 4) = cvt_pk_bf16(xv[0][j] * w0, xv[1][j] * w1); }
#pragma unroll
            for (int k = 0; k < 2; ++k) raw1[k] = *(const u32x2*)(pc + (2 * tp1 + k) * PROJ_LD + col1);
        }
        lds_barrier();
        if (w == 0 && c + 1 < 65) scan(c + 1, dt_next);
        __builtin_amdgcn_sched_barrier(0);
        f32x4 acc_y[2], acc_cb[2];
#pragma unroll
        for (int i = 0; i < 2; ++i) { acc_y[i] = (f32x4){0.f, 0.f, 0.f, 0.f}; acc_cb[i] = (f32x4){0.f, 0.f, 0.f, 0.f}; }
        bf16x8 f_ah[4], f_ab[4], f_cf[4][2];
#pragma unroll
        for (int kb = 0; kb < 4; ++kb) { f_ah[kb] = FRAG(h_bf, 272, 16 * wp + fr, 32 * kb + 8 * fq); f_ab[kb] = FRAG(B_rm, 272, 16 * wp + fr, 32 * kb + 8 * fq);
#pragma unroll
            for (int i = 0; i < 2; ++i) f_cf[kb][i] = FRAG(C_rm, 272, 16 * (2 * wl + i) + fr, 32 * kb + 8 * fq); }
        __builtin_amdgcn_sched_barrier(0);
#pragma unroll
        for (int kb = 0; kb < 4; ++kb)
#pragma unroll
            for (int i = 0; i < 2; ++i) {
                acc_y[i] = __builtin_amdgcn_mfma_f32_16x16x32_bf16(f_ah[kb], f_cf[kb][i], acc_y[i], 0, 0, 0);
                acc_cb[i] = __builtin_amdgcn_mfma_f32_16x16x32_bf16(f_ab[kb], f_cf[kb][i], acc_cb[i], 0, 0, 0); }
        bf16x8 f_xw[2], f_bt[2][4];
#pragma unroll
        for (int kb = 0; kb < 2; ++kb) { f_xw[kb] = *(const LAS bf16x8*)(xdtwT + (16 * wp + fr) * 144 + (((16 * kb + 4 * fq) ^ (4 * ((2 * wp + (fr >> 3)) & 7))) * 4));
#pragma unroll
            for (int q = 0; q < 4; ++q) f_bt[kb][q] = *(const LAS bf16x8*)(BT + (16 * (4 * wl + q) + fr) * 144 + (((8 * kb + 2 * fq) ^ ((8 * wl + 2 * q) & 14)) * 8)); }
        __builtin_amdgcn_sched_barrier(0);
#pragma unroll
        for (int i = 0; i < 2; ++i) { const int l = 16 * (2 * wl + i) + fr; const float csl = cs_s[l], el = __expf(csl);
            const f32x4 css = *(const LAS f32x4*)(cs_s + 16 * wp + 4 * fq);
            float m[4];
#pragma unroll
            for (int r = 0; r < 4; ++r) { acc_y[i][r] *= el; const int sidx = 16 * wp + 4 * fq + r; m[r] = sidx <= l ? acc_cb[i][r] * __expf(csl - css[r]) : 0.f; }
            u32x2 o; o.x = cvt_pk_bf16(m[0], m[1]); o.y = cvt_pk_bf16(m[2], m[3]);
            *(LAS u32x2*)(M_s + l * 144 + (16 * wp + 4 * fq) * 2) = o; }
        __builtin_amdgcn_sched_barrier(0);
        { const float elast = __expf(cs_last);
#pragma unroll
            for (int q = 0; q < 4; ++q) acc_h[q] *= elast;
#pragma unroll
            for (int kb = 0; kb < 2; ++kb)
#pragma unroll
                for (int q = 0; q < 4; ++q) acc_h[q] = __builtin_amdgcn_mfma_f32_16x16x32_bf16(f_bt[kb][q], f_xw[kb], acc_h[q], 0, 0, 0); }
        lds_barrier();
        bf16x8 f_xd[2], f_mf[2][2];
#pragma unroll
        for (int kb = 0; kb < 2; ++kb) { f_xd[kb] = *(const LAS bf16x8*)(xdtT + (16 * wp + fr) * 144 + (((16 * kb + 4 * fq) ^ (4 * ((2 * wp + (fr >> 3)) & 7))) * 4));
#pragma unroll
            for (int i = 0; i < 2; ++i) f_mf[kb][i] = FRAG(M_s, 144, 16 * (2 * wl + i) + fr, 32 * kb + 8 * fq); }
        __builtin_amdgcn_sched_barrier(0);
#pragma unroll
        for (int kb = 0; kb < 2; ++kb)
#pragma unroll
            for (int i = 0; i < 2; ++i) acc_y[i] = __builtin_amdgcn_mfma_f32_16x16x32_bf16(f_xd[kb], f_mf[kb][i], acc_y[i], 0, 0, 0);
#pragma unroll
        for (int q = 0; q < 4; ++q) { u32x2 o; o.x = cvt_pk_bf16(acc_h[q][0], acc_h[q][1]); o.y = cvt_pk_bf16(acc_h[q][2], acc_h[q][3]);
            *(LAS u32x2*)(h_bf + (16 * wp + fr) * 272 + (16 * (4 * wl + q) + 4 * fq) * 2) = o; }
#pragma unroll
        for (int i = 0; i < 2; ++i) { const int l = 16 * (2 * wl + i) + fr;
            const u32x2 xr = *(const LAS u32x2*)(xs_rm + l * 144 + (16 * wp + 4 * fq) * 2);
            const float xv[4] = {__uint_as_float(xr.x << 16), __uint_as_float(xr.x & 0xffff0000u), __uint_as_float(xr.y << 16), __uint_as_float(xr.y & 0xffff0000u)};
            const float zv[4] = {__uint_as_float(zraw[i].x << 16), __uint_as_float(zraw[i].x & 0xffff0000u), __uint_as_float(zraw[i].y << 16), __uint_as_float(zraw[i].y & 0xffff0000u)};
            float o[4], ss = 0.f;
#pragma unroll
            for (int r = 0; r < 4; ++r) { o[r] = (acc_y[i][r] + Dsk * xv[r]) * silu_f(zv[r]); ss += o[r] * o[r]; }
            { u32x2 ov; ov.x = cvt_pk_bf16(o[0], o[1]); ov.y = cvt_pk_bf16(o[2], o[3]); *(u32x2*)((bf16_t*)proj_row(ws, yrow[i]) + C_Z + head * 64 + 16 * wp + 4 * fq) = ov; }
            ss += __shfl_xor(ss, 16); ss += __shfl_xor(ss, 32);
            if (fq == 0) ssq_s[wp * 64 + l] = ss; }
        lds_barrier();
        { const int l = t & 63, pos = ssd_pos(c, l); const bool ok = t < 64 && pos >= 0 && (pos >= NMETA || b == 0);
            ((float*)(ws + OFF_SSQ))[(size_t)(ok ? rowof(b, pos) : XROWS + 255) * 32 + head] = (ssq_s[l] + ssq_s[64 + l]) + (ssq_s[128 + l] + ssq_s[192 + l]); }
#pragma unroll
        for (int i = 0; i < 2; ++i) zraw[i] = *(const u32x2*)(pc + (16 * (2 * wl + i) + fr) * PROJ_LD + C_Z + head * 64 + 16 * wp + 4 * fq);
    };
    for (int c = 0; c < 65; c += 2) {
        chunk(c, raw0A, raw1A, zA, dtA, dtB);
        if (c + 1 < 65) chunk(c + 1, raw0B, raw1B, zB, dtB, dtA);
    }
    __syncthreads();
}

__device__ __forceinline__ void attn_item(const Params& p, LAS unsigned char* lds, int b, int qb, int kv) {
    unsigned char* ws = p.ws;
    const int t = otid(), lane = t & 63, w = __builtin_amdgcn_readfirstlane(t >> 6), fr = lane & 15, fq = lane >> 4, P0 = qb * 128;
    LAS unsigned char* K_s = lds;
    LAS unsigned char* VT_s = lds + 39168;
    const int g = w & 3, hq = kv * 4 + g;
    auto qload = [&](const int i4, bf16x8 (&q)[2]) __attribute__((always_inline)) {
        const int a = (w >> 2) + 2 * i4, posbase = P0 + 16 * a;
        if (!(posbase >= NPOS || (posbase < NMETA && b != 0))) { const bf16_t* qp = proj_row(ws, rowof(b, posbase + fr)) + C_Q + hq * 64 + 8 * fq;
            q[0] = *(const bf16x8*)qp; q[1] = *(const bf16x8*)(qp + 32); }
    };
    bf16x8 qn[2] = {}; qload(0, qn);
    __syncthreads();
    for (int task = t; task < 544; task += 512) {
        const int sg = task >> 3, dg = task & 7;
        u32x4 kr[4], vr[4];
#pragma unroll
        for (int i = 0; i < 4; ++i) { const int slot = 4 * sg + i, kpos = slot < 256 ? P0 - 128 + slot : slot - 256;
            if (kpos >= 0 && kpos < NPOS) { const bf16_t* pr = proj_row(ws, rowof(b, kpos)); kr[i] = *(const u32x4*)(pr + C_K + kv * 64 + dg * 8); vr[i] = *(const u32x4*)(pr + C_V + kv * 64 + dg * 8); }
            else { kr[i] = (u32x4){0u, 0u, 0u, 0u}; vr[i] = (u32x4){0u, 0u, 0u, 0u}; } }
#pragma unroll
        for (int i = 0; i < 4; ++i) *(LAS u32x4*)(K_s + (4 * sg + i) * 144 + dg * 16) = kr[i];
#pragma unroll
        for (int j = 0; j < 8; ++j) { u32x2 o; o.x = bf_pair(vr[0][j >> 1], vr[1][j >> 1], j); o.y = bf_pair(vr[2][j >> 1], vr[3][j >> 1], j);
            *(LAS u32x2*)(VT_s + (dg * 8 + j) * 560 + sg * 8) = o; }
    }
    __syncthreads();
    const float slope = exp2f(-0.5f * (float)(hq + 1)), sink = p.in[11][hq];
    for (int i4 = 0; i4 < 4; ++i4) {
        const int a = (w >> 2) + 2 * i4, posbase = P0 + 16 * a;
        bf16x8 qf[2]; qf[0] = qn[0]; qf[1] = qn[1];
        if (i4 + 1 < 4) qload(i4 + 1, qn);
        if (posbase >= NPOS || (posbase < NMETA && b != 0)) continue;
        const int pos = posbase + fr, row = rowof(b, pos), ct0 = a & ~1;
        f32x4 S[11];
        bf16x8 kf[11][2];
#pragma unroll
        for (int ct = 0; ct < 11; ++ct) { const int srow = ct < 10 ? 16 * (ct0 + ct) + fr : 256 + fr;
#pragma unroll
            for (int kb = 0; kb < 2; ++kb) kf[ct][kb] = FRAG(K_s, 144, srow, 32 * kb + 8 * fq); }
        __builtin_amdgcn_sched_barrier(0);
#pragma unroll
        for (int ct = 0; ct < 11; ++ct) { S[ct] = (f32x4){0.f, 0.f, 0.f, 0.f};
#pragma unroll
            for (int kb = 0; kb < 2; ++kb) S[ct] = __builtin_amdgcn_mfma_f32_16x16x32_bf16(kf[ct][kb], qf[kb], S[ct], 0, 0, 0); }
        float mx = sink;
        if (qb >= 2) {
            const int D0 = 16 * (a - ct0) + 128 + fr - 4 * fq;
            const float sD0 = -slope * (float)D0;
#pragma unroll
            for (int ct = 0; ct < 11; ++ct)
#pragma unroll
                for (int r = 0; r < 4; ++r) {
                    float sv;
                    if (ct < 10) { sv = S[ct][r] * 0.125f + (sD0 + slope * (float)(16 * ct + r));
                        if (ct < 2 || ct > 7) { const int dist = D0 - 16 * ct - r; sv = (dist >= 0 && dist < 128) ? sv : -1e30f; } }
                    else sv = S[ct][r] * 0.125f;
                    S[ct][r] = sv; mx = fmaxf(mx, sv);
                }
        } else {
#pragma unroll
            for (int ct = 0; ct < 11; ++ct)
#pragma unroll
                for (int r = 0; r < 4; ++r) {
                    float sv; bool ok;
                    if (ct < 10) { const int slot = 16 * (ct0 + ct) + 4 * fq + r, dist = 16 * a + fr + 128 - slot; ok = dist >= 0 && dist < 128 && (P0 - 128 + slot) >= NMETA; sv = S[ct][r] * 0.125f - slope * (float)dist; }
                    else { ok = (4 * fq + r) <= pos; sv = S[ct][r] * 0.125f; }
                    sv = ok ? sv : -1e30f; S[ct][r] = sv; mx = fmaxf(mx, sv);
                }
        }
        mx = fmaxf(mx, __shfl_xor(mx, 16)); mx = fmaxf(mx, __shfl_xor(mx, 32));
        float sum = 0.f;
#pragma unroll
        for (int ct = 0; ct < 11; ++ct)
#pragma unroll
            for (int r = 0; r < 4; ++r) { const float e = __expf(S[ct][r] - mx); S[ct][r] = e; sum += e; }
        sum += __shfl_xor(sum, 16); sum += __shfl_xor(sum, 32);
        sum += __expf(sink - mx);
        f32x4 acc_o[4];
#pragma unroll
        for (int dt = 0; dt < 4; ++dt) acc_o[dt] = (f32x4){0.f, 0.f, 0.f, 0.f};
        u32x4 vw[2][4];
#pragma unroll
        for (int dt = 0; dt < 4; ++dt) { const int sbase = 16 * ct0;
            const u32x2 v0 = *(const LAS u32x2*)(VT_s + (16 * dt + fr) * 560 + (sbase + 4 * fq) * 2), v1 = *(const LAS u32x2*)(VT_s + (16 * dt + fr) * 560 + (sbase + 16 + 4 * fq) * 2);
            vw[0][dt] = (u32x4){v0.x, v0.y, v1.x, v1.y}; }
#pragma unroll
        for (int kb5 = 0; kb5 < 6; ++kb5) {
            if (kb5 + 1 < 6) {
#pragma unroll
                for (int dt = 0; dt < 4; ++dt) { const int sbase = kb5 + 1 < 5 ? 16 * (ct0 + 2 * (kb5 + 1)) : 256;
                    const u32x2 v0 = *(const LAS u32x2*)(VT_s + (16 * dt + fr) * 560 + (sbase + 4 * fq) * 2);
                    u32x2 v1 = (u32x2){0u, 0u};
                    if (kb5 + 1 < 5) v1 = *(const LAS u32x2*)(VT_s + (16 * dt + fr) * 560 + (sbase + 16 + 4 * fq) * 2);
                    vw[(kb5 + 1) & 1][dt] = (u32x4){v0.x, v0.y, v1.x, v1.y}; }
            }
            __builtin_amdgcn_sched_barrier(0);
            u32x4 pw; pw.x = cvt_pk_bf16(S[kb5 < 5 ? 2 * kb5 : 10][0], S[kb5 < 5 ? 2 * kb5 : 10][1]); pw.y = cvt_pk_bf16(S[kb5 < 5 ? 2 * kb5 : 10][2], S[kb5 < 5 ? 2 * kb5 : 10][3]);
            if (kb5 < 5) { pw.z = cvt_pk_bf16(S[kb5 < 5 ? 2 * kb5 + 1 : 10][0], S[kb5 < 5 ? 2 * kb5 + 1 : 10][1]); pw.w = cvt_pk_bf16(S[kb5 < 5 ? 2 * kb5 + 1 : 10][2], S[kb5 < 5 ? 2 * kb5 + 1 : 10][3]); }
            else { pw.z = 0u; pw.w = 0u; }
#pragma unroll
            for (int dt = 0; dt < 4; ++dt)
                acc_o[dt] = __builtin_amdgcn_mfma_f32_16x16x32_bf16(__builtin_bit_cast(bf16x8, vw[kb5 & 1][dt]), __builtin_bit_cast(bf16x8, pw), acc_o[dt], 0, 0, 0);
        }
        const float inv = 1.f / sum;
        bf16_t* op = (bf16_t*)proj_row(ws, row) + C_Q + hq * 64 + 4 * fq;
#pragma unroll
        for (int dt = 0; dt < 4; ++dt) { u32x2 o; o.x = cvt_pk_bf16(acc_o[dt][0] * inv, acc_o[dt][1] * inv); o.y = cvt_pk_bf16(acc_o[dt][2] * inv, acc_o[dt][3] * inv); *(u32x2*)(op + 16 * dt) = o; }
    }
    __syncthreads();
}

__device__ __forceinline__ void phase_mixer(const Params& p, LAS unsigned char* lds) {
    const int c = obid(), G = gridDim.x;
    for (int it = c; it < 256; it += G) ssd_item(p, lds, it >> 5, it & 31);
    for (int it = c; it < 8 * 33 * 4; it += G) {
        int kv, qb, b;
        if (it < 1024) { kv = it & 3; qb = (it >> 2) & 31; b = it >> 7; } else { const int j = it - 1024; kv = j & 3; qb = 32; b = j >> 2; }
        attn_item(p, lds, b, qb, kv); }
}

__device__ __forceinline__ void phase_e1(const Params& p) {
    const int tid_ = otid(), lane = tid_ & 63, gw = obid() * 8 + (tid_ >> 6), NGW = gridDim.x * 8;
    f32x4 w1v[4], w2v[4];
#pragma unroll
    for (int j = 0; j < 4; ++j) { w1v[j] = *(const f32x4*)(p.in[14] + (lane + 64 * j) * 4); w2v[j] = *(const f32x4*)(p.in[15] + (lane + 64 * j) * 4); }
    for (int r0 = gw; r0 < MROWS; r0 += 4 * NGW) {
        f32x4 v[4][4], hv[4][4];
#pragma unroll
        for (int i = 0; i < 4; ++i) { const int r = r0 + i * NGW; const bool real = r < XROWS + NMETA; const int rc = real ? r : 0;
            const bf16_t* mx = (const bf16_t*)(p.ws + OFF_MIX) + (size_t)rc * D;
            const float* hs = rc < XROWS ? p.in[0] + (size_t)rc * D : p.in[1] + (size_t)(rc - XROWS) * D;
#pragma unroll
            for (int j = 0; j < 4; ++j) { const u32x2 m2 = __builtin_nontemporal_load((const u32x2*)(mx + (lane + 64 * j) * 4));
                v[i][j] = (f32x4){__uint_as_float(m2.x << 16), __uint_as_float(m2.x & 0xffff0000u), __uint_as_float(m2.y << 16), __uint_as_float(m2.y & 0xffff0000u)};
                hv[i][j] = __builtin_nontemporal_load((const f32x4*)(hs + (lane + 64 * j) * 4)); } }
#pragma unroll
        for (int i = 0; i < 4; ++i) { const int r = r0 + i * NGW;
            if (r >= MROWS) continue;
            const bool real = r < XROWS + NMETA;
            bf16_t* dst = (bf16_t*)(p.ws + OFF_HN2) + (size_t)r * D;
            float s = 0.f;
#pragma unroll
            for (int j = 0; j < 4; ++j) s += (v[i][j][0] * v[i][j][0] + v[i][j][1] * v[i][j][1]) + (v[i][j][2] * v[i][j][2] + v[i][j][3] * v[i][j][3]);
            const float rs1 = rsqrtf(wave_sum(s) * (1.f / D) + EPS);
            float s2 = 0.f;
#pragma unroll
            for (int j = 0; j < 4; ++j)
#pragma unroll
                for (int q = 0; q < 4; ++q) { v[i][j][q] = hv[i][j][q] + v[i][j][q] * rs1 * w1v[j][q]; s2 += v[i][j][q] * v[i][j][q]; }
            const float rs2 = real ? rsqrtf(wave_sum(s2) * (1.f / D) + EPS) : 0.f;
#pragma unroll
            for (int j = 0; j < 4; ++j) {
                u32x2 o; o.x = cvt_pk_bf16(v[i][j][0] * rs2 * w2v[j][0], v[i][j][1] * rs2 * w2v[j][1]); o.y = cvt_pk_bf16(v[i][j][2] * rs2 * w2v[j][2], v[i][j][3] * rs2 * w2v[j][3]);
                *(u32x2*)(dst + (lane + 64 * j) * 4) = o; }
        }
    }
}
__device__ __forceinline__ void phase_e3(const Params& p) {
    const int tid_ = otid(), lane = tid_ & 63, gw = obid() * 8 + (tid_ >> 6), NGW = gridDim.x * 8;
    f32x4 w3v[4], w1v[4];
#pragma unroll
    for (int j = 0; j < 4; ++j) { w3v[j] = *(const f32x4*)(p.in[20] + (lane + 64 * j) * 4); w1v[j] = *(const f32x4*)(p.in[14] + (lane + 64 * j) * 4); }
    for (int r0 = gw; r0 < XROWS; r0 += 4 * NGW) {
        f32x4 hv[4][4]; u32x2 fr2[4][4], mr2[4][4];
#pragma unroll
        for (int i = 0; i < 4; ++i) { const int r = r0 + i * NGW; const int rc = r < XROWS ? r : 0;
#pragma unroll
            for (int j = 0; j < 4; ++j) { fr2[i][j] = __builtin_nontemporal_load((const u32x2*)((const bf16_t*)(p.ws + OFF_FFN) + (size_t)rc * D + (lane + 64 * j) * 4));
                mr2[i][j] = __builtin_nontemporal_load((const u32x2*)((const bf16_t*)(p.ws + OFF_MIX) + (size_t)rc * D + (lane + 64 * j) * 4));
                hv[i][j] = __builtin_nontemporal_load((const f32x4*)(p.in[0] + (size_t)rc * D + (lane + 64 * j) * 4)); } }
#pragma unroll
        for (int i = 0; i < 4; ++i) { const int r = r0 + i * NGW;
            if (r >= XROWS) continue;
            f32x4 v[4], mv[4];
            float s = 0.f, sm = 0.f;
#pragma unroll
            for (int j = 0; j < 4; ++j) {
                v[j] = (f32x4){__uint_as_float(fr2[i][j].x << 16), __uint_as_float(fr2[i][j].x & 0xffff0000u), __uint_as_float(fr2[i][j].y << 16), __uint_as_float(fr2[i][j].y & 0xffff0000u)};
                mv[j] = (f32x4){__uint_as_float(mr2[i][j].x << 16), __uint_as_float(mr2[i][j].x & 0xffff0000u), __uint_as_float(mr2[i][j].y << 16), __uint_as_float(mr2[i][j].y & 0xffff0000u)};
                s += (v[j][0] * v[j][0] + v[j][1] * v[j][1]) + (v[j][2] * v[j][2] + v[j][3] * v[j][3]);
                sm += (mv[j][0] * mv[j][0] + mv[j][1] * mv[j][1]) + (mv[j][2] * mv[j][2] + mv[j][3] * mv[j][3]); }
            const float rs = rsqrtf(wave_sum(s) * (1.f / D) + EPS), rs1 = rsqrtf(wave_sum(sm) * (1.f / D) + EPS);
#pragma unroll
            for (int j = 0; j < 4; ++j) { f32x4 o;
#pragma unroll
                for (int q = 0; q < 4; ++q) o[q] = (hv[i][j][q] + mv[j][q] * rs1 * w1v[j][q]) + v[j][q] * rs * w3v[j][q];
                __builtin_nontemporal_store(o, (f32x4*)(p.out + (size_t)r * D + (lane + 64 * j) * 4)); }
        }
    }
}
__device__ __forceinline__ void phase_e2(const Params& p) {
    const int t = otid(), tc = t & 7, tr = t >> 3, lr0 = tr * 4;
    bf16_t* U = (bf16_t*)(p.ws + OFF_U); const bf16_t* halo = (const bf16_t*)(p.ws + OFF_HALO);
    const float* cw = p.in[17]; const float* cb = p.in[18];
    const int G = gridDim.x, NIT = 128 * 44;
    for (int it0 = obid(); it0 < NIT; it0 += 2 * G) {
        u32x4 ra[2][6], rg[2][6];
#pragma unroll
        for (int q = 0; q < 2; ++q) { const int it = it0 + q * G < NIT ? it0 + q * G : it0; const int pm = it / 44, c = (it % 44) * 64 + tc * 8;
#pragma unroll
            for (int k = 0; k < 6; ++k) { const int lr = lr0 - 2 + k;
                const bf16_t* src = lr >= 0 ? U + (size_t)(pm * 256 + lr) * U_LD : halo + (size_t)(((pm & 15) == 0 ? META_TILE : pm - 1) * 2 + (lr + 2)) * U_LD;
                ra[q][k] = *(const u32x4*)(src + c); rg[q][k] = *(const u32x4*)(src + FF + c); } }
        __syncthreads();
#pragma unroll
        for (int q = 0; q < 2; ++q) { const int it = it0 + q * G < NIT ? it0 + q * G : it0; const int pm = it / 44, c = (it % 44) * 64 + tc * 8; u32x4 o[4];
            float wa[3][8], wg[3][8], ba[8], bg[8];
#pragma unroll
            for (int j = 0; j < 8; ++j) { ba[j] = cb[c + j]; bg[j] = cb[FF + c + j];
#pragma unroll
                for (int k = 0; k < 3; ++k) { wa[k][j] = cw[k * 5632 + c + j]; wg[k][j] = cw[k * 5632 + FF + c + j]; } }
#pragma unroll
            for (int i = 0; i < 4; ++i) { float av[8], gv[8];
#pragma unroll
                for (int j = 0; j < 8; ++j) { av[j] = ba[j]; gv[j] = bg[j]; }
#pragma unroll
                for (int k = 0; k < 3; ++k) { float ua[8], ug[8]; unpack8(ra[q][i + k], ua); unpack8(rg[q][i + k], ug);
#pragma unroll
                    for (int j = 0; j < 8; ++j) { av[j] += wa[k][j] * ua[j]; gv[j] += wg[k][j] * ug[j]; } }
                float r[8];
#pragma unroll
                for (int j = 0; j < 8; ++j) r[j] = silu_f(av[j]) * gv[j];
                o[i] = pack8(r); }
            if (it0 + q * G < NIT) {
#pragma unroll
                for (int i = 0; i < 4; ++i) *(u32x4*)(U + (size_t)(pm * 256 + lr0 + i) * U_LD + c) = o[i]; } }
    }
}

__device__ __forceinline__ void phase_conv(const Params& p) {
    const int t = otid(), tc = t & 7, tr = t >> 3, lr0 = tr * 4;
    unsigned char* ws = p.ws;
    const bf16_t* halo = (const bf16_t*)(ws + OFF_HALO1);
    const float* cw = p.in[4]; const float* cb = p.in[5];
    const int G = gridDim.x, NIT = 129 * 48;
    for (int it0 = obid(); it0 < NIT; it0 += 2 * G) {
        u32x4 raw[2][7];
#pragma unroll
        for (int q = 0; q < 2; ++q) { const int it = it0 + q * G < NIT ? it0 + q * G : it0; const int pml = it / 48, c = (it % 48) * 64 + tc * 8;
            const bool meta = pml == META_TILE; const int pm = pml;
            const bf16_t* base = (const bf16_t*)(ws + OFF_PROJ) + (size_t)(pml * 256) * PROJ_LD;
#pragma unroll
            for (int k = 0; k < 7; ++k) { const int lr = lr0 - 3 + k;
                if (lr >= 0) raw[q][k] = *(const u32x4*)(base + (size_t)lr * PROJ_LD + C_XS + c);
                else if (meta) raw[q][k] = (u32x4){0u, 0u, 0u, 0u};
                else raw[q][k] = *(const u32x4*)(halo + (size_t)(((pm & 15) == 0 ? META_TILE : pm - 1) * 3 + (lr + 3)) * 3072 + c); } }
        __syncthreads();
#pragma unroll
        for (int q = 0; q < 2; ++q) { const int it = it0 + q * G < NIT ? it0 + q * G : it0; const int pml = it / 48, c = (it % 48) * 64 + tc * 8;
            bf16_t* base = (bf16_t*)(ws + OFF_PROJ) + (size_t)(pml * 256) * PROJ_LD;
            float wv[5][8];
#pragma unroll
            for (int j = 0; j < 8; ++j) { wv[4][j] = cb[c + j];
#pragma unroll
                for (int k = 0; k < 4; ++k) wv[k][j] = cw[k * 3072 + c + j]; }
#pragma unroll
            for (int i = 0; i < 4; ++i) { float a[8];
#pragma unroll
                for (int j = 0; j < 8; ++j) a[j] = wv[4][j];
#pragma unroll
                for (int k = 0; k < 4; ++k) { float u[8]; unpack8(raw[q][i + k], u);
#pragma unroll
                    for (int j = 0; j < 8; ++j) a[j] += wv[k][j] * u[j]; }
#pragma unroll
                for (int j = 0; j < 8; ++j) a[j] = silu_f(a[j]);
                if (it0 + q * G < NIT) *(u32x4*)(base + (size_t)(lr0 + i) * PROJ_LD + C_XS + c) = pack8(a); } }
    }
}

__device__ __forceinline__ f32x4 skinny_dot(const bf16_t* A, int lda, const bf16_t* Bt, int ldb, int j, int K, int fr, int fq, f32x4 acc) {
    const bf16_t* ap = A + (size_t)fr * lda + 8 * fq; const bf16_t* bp = Bt + (size_t)(16 * j + fr) * ldb + 8 * fq;
#pragma unroll 8
    for (int k0 = 0; k0 < K; k0 += 32) acc = __builtin_amdgcn_mfma_f32_16x16x32_bf16(*(const bf16x8*)(bp + k0), *(const bf16x8*)(ap + k0), acc, 0, 0, 0);
    return acc;
}
__device__ __forceinline__ f32x4 skinny_splitk(const bf16_t* A, int lda, const bf16_t* Bt, int ldb, int j, int K, LAS float* red, int t) {
    const int lane = t & 63, w = t >> 6, fr = lane & 15, fq = lane >> 4, ks = K >> 3;
    const f32x4 part = skinny_dot(A + w * ks, lda, Bt + w * ks, ldb, j, ks, fr, fq, (f32x4){0.f, 0.f, 0.f, 0.f});
    __syncthreads();
    *(LAS f32x4*)(red + (w * 64 + lane) * 4) = part;
    __syncthreads();
    f32x4 sum = {0.f, 0.f, 0.f, 0.f};
    if (w == 0) {
#pragma unroll
        for (int i = 0; i < 8; ++i) sum += *(const LAS f32x4*)(red + (i * 64 + lane) * 4); }
    return sum;
}
__device__ __forceinline__ void meta_g2(const Params& p, LAS unsigned char* lds) {
    unsigned char* ws = p.ws;
    const int t = otid(), lane = t & 63, fr = lane & 15, fq = lane >> 4;
    for (int j = obid(); j < 64; j += gridDim.x) {
        const bf16_t* A = (const bf16_t*)(ws + OFF_PROJ) + (size_t)XROWS * PROJ_LD; const bf16_t* W = (const bf16_t*)(ws + OFF_WG2);
        const f32x4 a1 = skinny_splitk(A + C_Z, PROJ_LD, W, A2_LD, j, 2048, (LAS float*)lds, t), a2 = skinny_splitk(A + C_Q, PROJ_LD, W + 2048, A2_LD, j, 1024, (LAS float*)lds, t);
        if (t >= 64) continue;
        const f32x4* sq = (const f32x4*)((const float*)(ws + OFF_SSQ) + (size_t)(XROWS + fr) * 32);
        float ssum = 0.f;
#pragma unroll
        for (int i = 0; i < 8; ++i) { const f32x4 v = sq[i]; ssum += (v[0] + v[1]) + (v[2] + v[3]); }
        const float rs = rsqrtf(ssum * (1.f / 2048.f) + EPS);
        const bf16_t* pr = (const bf16_t*)(ws + OFF_PROJ) + (size_t)(XROWS + fr) * PROJ_LD + 16 * j + 4 * fq;
        const u32x2 gsr = *(const u32x2*)(pr + C_GS), gar = *(const u32x2*)(pr + C_GA);
        const float gs[4] = {__uint_as_float(gsr.x << 16), __uint_as_float(gsr.x & 0xffff0000u), __uint_as_float(gsr.y << 16), __uint_as_float(gsr.y & 0xffff0000u)};
        const float ga[4] = {__uint_as_float(gar.x << 16), __uint_as_float(gar.x & 0xffff0000u), __uint_as_float(gar.y << 16), __uint_as_float(gar.y & 0xffff0000u)};
        float o[4];
#pragma unroll
        for (int r = 0; r < 4; ++r) o[r] = sigmoid_f(gs[r]) * rs * a1[r] + sigmoid_f(ga[r]) * a2[r];
        u32x2 ov; ov.x = cvt_pk_bf16(o[0], o[1]); ov.y = cvt_pk_bf16(o[2], o[3]);
        *(u32x2*)((bf16_t*)(ws + OFF_MBUF_META) + (size_t)fr * D + 16 * j + 4 * fq) = ov;
    }
}
__device__ __forceinline__ void meta_gates(const Params& p, LAS unsigned char* lds) {
    unsigned char* ws = p.ws;
    const int t = otid(), lane = t & 63, fr = lane & 15, fq = lane >> 4;
    for (int j = obid(); j < 128; j += gridDim.x) {
        const f32x4 a = skinny_splitk((const bf16_t*)(ws + OFF_HN_META), D, (const bf16_t*)(ws + OFF_WIN) + (size_t)(26 * 256) * D, D, j, 1024, (LAS float*)lds, t);
        if (t >= 64) continue;
        u32x2 ov; ov.x = cvt_pk_bf16(a[0], a[1]); ov.y = cvt_pk_bf16(a[2], a[3]);
        *(u32x2*)((bf16_t*)(ws + OFF_PROJ) + (size_t)(XROWS + fr) * PROJ_LD + C_GS + 16 * j + 4 * fq) = ov;
    }
}
__device__ __forceinline__ void meta_g3(const Params& p, LAS unsigned char* lds) {
    unsigned char* ws = p.ws;
    const int t = otid(), lane = t & 63, fr = lane & 15, fq = lane >> 4;
    for (int j = obid(); j < 64; j += gridDim.x) {
        const f32x4 a = skinny_splitk((const bf16_t*)(ws + OFF_MBUF_META), D, (const bf16_t*)(ws + OFF_WMIX), D, j, 1024, (LAS float*)lds, t);
        if (t >= 64) continue;
        u32x2 ov; ov.x = cvt_pk_bf16(a[0], a[1]); ov.y = cvt_pk_bf16(a[2], a[3]);
        *(u32x2*)((bf16_t*)(ws + OFF_MIX) + (size_t)(XROWS + fr) * D + 16 * j + 4 * fq) = ov;
    }
}
__device__ __forceinline__ void meta_g4(const Params& p, LAS unsigned char* lds) {
    unsigned char* ws = p.ws;
    const int t = otid(), lane = t & 63, fr = lane & 15, fq = lane >> 4;
    for (int j = obid(); j < 352; j += gridDim.x) {
        const f32x4 a = skinny_splitk((const bf16_t*)(ws + OFF_HN2) + (size_t)XROWS * D, D, (const bf16_t*)(ws + OFF_WUP), D, j, 1024, (LAS float*)lds, t);
        if (t >= 64) continue;
        u32x2 ov; ov.x = cvt_pk_bf16(a[0], a[1]); ov.y = cvt_pk_bf16(a[2], a[3]);
        const int np = 16 * j + 4 * fq, col = ((np & 128) ? FF : 0) + 128 * (np >> 8) + (np & 127);
        if (fr >= 14) *(u32x2*)((bf16_t*)(ws + OFF_RAWM) + (size_t)(fr - 14) * U_LD + col) = ov;
    }
}

#define XB_TMO      128
#define XB_XCNT(j)  (256  + 64 * (j))
#define XB_XSUB(j)  (1280 + 64 * (j))
#define XB_XGEN(j)  (2304 + 64 * (j))
#define XB_TOP      3328
#define XB_TOPGEN   3392
#define XCD_BAR_WORDS 3456
#define XB_SPIN_CAP (1u << 18)

__device__ __forceinline__ unsigned xb_ld(unsigned* p)              { return __hip_atomic_load(p, __ATOMIC_RELAXED, __HIP_MEMORY_SCOPE_AGENT); }
__device__ __forceinline__ unsigned xb_add(unsigned* p, unsigned v) { return __hip_atomic_fetch_add(p, v, __ATOMIC_RELAXED, __HIP_MEMORY_SCOPE_AGENT); }
__device__ __forceinline__ unsigned xb_xcc_id() { return (unsigned)__builtin_amdgcn_s_getreg((3 << 11) | 20) & 0xFu; }
#define XB_SPIN(cond, bar) do { unsigned _sp = 0; while (cond) { __builtin_amdgcn_s_sleep(1); \
    if ((++_sp & 255u) == 0u) { if (xb_ld(&(bar)[XB_TMO])) break; if (_sp > XB_SPIN_CAP) { atomicAdd(&(bar)[XB_TMO], 1u); break; } } } } while (0)

struct XcdBarrier {
    unsigned* bar; unsigned x;
    volatile LAS unsigned* st;
};

__device__ __forceinline__ XcdBarrier xcd_barrier_post(unsigned* bar, volatile LAS unsigned* st) {
    XcdBarrier b; b.bar = bar; b.x = xb_xcc_id(); b.st = st;
    if (threadIdx.x == 0) (void)xb_add(&bar[XB_XCNT(b.x)], 1u);
    return b;
}
__device__ __forceinline__ void xcd_barrier_complete(unsigned* bar, unsigned x, unsigned& nloc, unsigned& nx) {
    const unsigned G = gridDim.x * gridDim.y * gridDim.z;
    unsigned sum, cnt, mine, sp = 0u;
    for (;;) {
        sum = 0u; cnt = 0u; mine = 0u;
#pragma unroll
        for (unsigned j = 0; j < 16; ++j) { const unsigned c = xb_ld(&bar[XB_XCNT(j)]); sum += c; cnt += (c > 0u) ? 1u : 0u; mine = (j == x) ? c : mine; }
        if (sum == G) break;
        __builtin_amdgcn_s_sleep(1);
        if ((++sp & 255u) == 0u) { if (xb_ld(&bar[XB_TMO])) break; if (sp > XB_SPIN_CAP) { atomicAdd(&bar[XB_TMO], 1u); break; } }
    }
    nloc = mine > 0u ? mine : 1u; nx = cnt > 0u ? cnt : 1u;
}

__device__ __forceinline__ void xcd_barrier(const XcdBarrier& b) {
    asm volatile("s_waitcnt vmcnt(0)" ::: "memory");
    __syncthreads();
    if (threadIdx.x == 0) {
        unsigned* bar = b.bar;
        __builtin_amdgcn_s_waitcnt(0);
        unsigned nloc = b.st[0], nx = b.st[1];
        if (nloc == 0u) { xcd_barrier_complete(bar, b.x, nloc, nx); b.st[0] = nloc; b.st[1] = nx; }
        const unsigned old = xb_add(&bar[XB_XSUB(b.x)], 1u);
        const unsigned gen = old / nloc;
        if (old + 1u == (gen + 1u) * nloc) {
            __builtin_amdgcn_fence(__ATOMIC_RELEASE, "agent");
            asm volatile("s_waitcnt vmcnt(0)" ::: "memory");
            const unsigned og = xb_add(&bar[XB_TOP], 1u);
            const unsigned tg = og / nx;
            if (og + 1u == (tg + 1u) * nx) xb_add(&bar[XB_TOPGEN], 1u);
            else XB_SPIN(xb_ld(&bar[XB_TOPGEN]) == tg, bar);
            __builtin_amdgcn_fence(__ATOMIC_ACQUIRE, "agent");
            xb_add(&bar[XB_XGEN(b.x)], 1u);
            asm volatile("s_waitcnt vmcnt(0)" ::: "memory");
        } else {
            XB_SPIN(xb_ld(&bar[XB_XGEN(b.x)]) == gen, bar);
            __builtin_amdgcn_fence(__ATOMIC_ACQUIRE, "agent");
            asm volatile("s_waitcnt vmcnt(0)" ::: "memory");
        }
    }
    __syncthreads();
}


__device__ __forceinline__ void sched_init(pg8::Sched& S, int nM, int nN, int parts, int mt0, int has_meta, int nt0, int nt1, const void* Ax, const void* Am, const void* B, size_t a_tile, size_t b_tile) {
    S.nM = nM; S.nN = nN; S.nwg = nM * nN; S.G = gridDim.x; S.c = obid(); S.parts = parts; S.mt0 = mt0; S.has_meta = has_meta; S.nt0 = nt0; S.nt1 = nt1;
    S.Ax = (const char*)Ax; S.Am = (const char*)Am; S.B = (const char*)B; S.a_tile = a_tile; S.b_tile = b_tile; S.pn_base = 0; S.pn_last = -1; S.a_part1 = (size_t)nt0 * 128;
}
__device__ __forceinline__ void run_phase(const Params& p, LAS unsigned char* lds, int ph) {
    unsigned char* ws = p.ws;
    pg8::Sched S;
    switch (ph) {
#ifndef PHM
#define PHM 0x7fff
#endif
#define PH_ON(x) ((PHM >> (x)) & 1)
    case 0: if (PH_ON(0)) phase_prep(p, lds); break;
    case 1: if (PH_ON(1)) {
        sched_init(S, 129, 27, 1, 0, 1, 16, 0, p.out, ws + OFF_HN_META, ws + OFF_WIN, (size_t)256 * D * 2, (size_t)256 * D * 2); S.pn_last = 34;
        EpiG1 E{ws, p.in[6], p.in[4], p.in[5]}; pg8::gemm_phase(lds, D, D, S, E); } break;
    case 2: if (PH_ON(2)) phase_mixer(p, lds); break;
    case 3: if (PH_ON(3)) {
        meta_gates(p, lds); __syncthreads();
        sched_init(S, 128, 8, 1, 0, 0, 16, 0, p.out, ws + OFF_HN_META, ws + OFF_WIN, (size_t)256 * D * 2, (size_t)256 * D * 2); S.pn_base = 26;
        EpiG1 E{ws, p.in[6], p.in[4], p.in[5]}; pg8::gemm_phase(lds, D, D, S, E); } break;
    case 4: if (PH_ON(4)) {
        meta_g2(p, lds); __syncthreads();
        sched_init(S, 128, 4, 2, 0, 0, 32, 16, ws + OFF_PROJ + (size_t)C_Z * 2, ws + OFF_PROJ, ws + OFF_WG2, (size_t)256 * PROJ_LD * 2, (size_t)256 * A2_LD * 2); S.a_part1 = (size_t)(C_Q - C_Z) * 2;
        EpiG2 E{ws, (bf16_t*)((unsigned char*)p.out + 64 * MiB)}; pg8::gemm_phase(lds, PROJ_LD, A2_LD, S, E); } break;
    case 5: if (PH_ON(5)) { meta_g3(p, lds); __syncthreads();
        sched_init(S, 128, 4, 1, 0, 0, 16, 0, (unsigned char*)p.out + 64 * MiB, ws + OFF_MBUF_META, ws + OFF_WMIX, (size_t)256 * D * 2, (size_t)256 * D * 2);
        EpiB16 E{(bf16_t*)(ws + OFF_MIX)}; pg8::gemm_phase(lds, D, D, S, E); } break;
    case 6: if (PH_ON(6)) phase_e1(p); break;
    case 7: if (PH_ON(7)) { meta_g4(p, lds); __syncthreads();
        sched_init(S, 128, 22, 1, 0, 0, 16, 0, ws + OFF_HN2, ws + OFF_HN2 + (size_t)128 * 256 * D * 2, ws + OFF_WUP, (size_t)256 * D * 2, (size_t)256 * D * 2);
        EpiG4F E{(bf16_t*)(ws + OFF_U), (bf16_t*)(ws + OFF_RAW), p.in[17], p.in[18]}; pg8::gemm_phase(lds, D, D, S, E); } break;
    case 8: if (PH_ON(8)) { sched_init(S, 128, 4, 1, 0, 0, 44, 0, ws + OFF_U, ws + OFF_U, ws + OFF_WDN, (size_t)256 * FF * 2, (size_t)256 * FF * 2);
        { pg8::Unit uu; int last = -1; for (int j = 0; S.next(j, uu); ++j) if (uu.pm != last) { ffn_fixup(p, uu.pm); last = uu.pm; } }
        asm volatile("s_waitcnt vmcnt(0)" ::: "memory"); __syncthreads();
        EpiB16 E{(bf16_t*)(ws + OFF_FFN)}; pg8::gemm_phase(lds, FF, FF, S, E); } break;
    case 9: if (PH_ON(9)) phase_e3(p); break;
    }
}

__global__ __launch_bounds__(512, 2) void fwd_kernel(Params p) {
    extern __shared__ __attribute__((aligned(16))) unsigned char shm[];
    LAS unsigned char* lds = (LAS unsigned char*)shm;
#ifndef REPEAT_MASK
#define REPEAT_MASK 0
#endif
    volatile LAS unsigned* st = (volatile LAS unsigned*)(lds + 131072);
    if (threadIdx.x == 0) { st[0] = 0u; st[1] = 0u; }
    __syncthreads();
    const XcdBarrier xb = xcd_barrier_post((unsigned*)(p.ws + OFF_BAR), st);
    for (int ph = p.ph_lo; ph < p.ph_hi; ++ph) {
        run_phase(p, lds, ph);
        if (REPEAT_MASK && ((REPEAT_MASK >> ph) & 1)) { cg::this_grid().sync(); run_phase(p, lds, ph); }
        if (ph + 1 < p.ph_hi) { if (p.ph_hi > NPHASE) cg::this_grid().sync(); else xcd_barrier(xb); }
    }
}

extern "C" void kernel_launch(void* const* d_in, const int* in_sizes, int n_in, void* d_out, int out_size, void* d_ws, size_t ws_size, hipStream_t stream) {
    static int grid = 0;
    if (grid == 0) {
        if (n_in != 21 || ws_size < WS_NEED) { fprintf(stderr, "kernel_launch: unexpected n_in %d / ws_size %zu\n", n_in, ws_size); grid = -1; return; }
        int dev = 0, cus = 0, per_cu = 0;
        hipGetDevice(&dev); hipDeviceGetAttribute(&cus, hipDeviceAttributeMultiprocessorCount, dev);
        hipFuncSetAttribute((const void*)fwd_kernel, hipFuncAttributeMaxDynamicSharedMemorySize, LDS_BYTES);
        hipOccupancyMaxActiveBlocksPerMultiprocessor(&per_cu, (const void*)fwd_kernel, 512, LDS_BYTES);
        if (per_cu < 1) { fprintf(stderr, "kernel_launch: occupancy query says %d\n", per_cu); per_cu = 1; }
        grid = cus;
    }
    if (grid < 0) return;
    Params p{};
    for (int i = 0; i < 21; ++i) p.in[i] = (const float*)d_in[i];
    p.out = (float*)d_out; p.ws = (unsigned char*)d_ws;
#if ONE_LAUNCH
    if (hipMemsetAsync((unsigned char*)d_ws + OFF_BAR, 0, XCD_BAR_WORDS * sizeof(unsigned), stream) != hipSuccess) { fprintf(stderr, "kernel_launch: memset of barrier words failed\n"); return; }
    p.ph_lo = 0; p.ph_hi = NPHASE;
    void* args[] = {&p};
    hipError_t e = hipLaunchCooperativeKernel((const void*)fwd_kernel, dim3(grid), dim3(512), args, LDS_BYTES, stream);
    if (e != hipSuccess) fprintf(stderr, "cooperative launch failed: %s (grid %d)\n", hipGetErrorString(e), grid);
#else
    for (int ph = 0; ph < NPHASE; ++ph) {
        p.ph_lo = ph; p.ph_hi = ph + 1;
        hipLaunchKernelGGL(fwd_kernel, dim3(grid), dim3(512), LDS_BYTES, stream, p);
    }
#endif
}
```
